# Optimizing an MI355X kernel written in HIP

```python
import math
import jax, jax.numpy as jnp
from jax import lax
import numpy as np

D_MODEL = 1024
BATCH = 16
SEQ = 2048
DEPTH = 2
DEC_BATCH = 32
DEC_SEQ = 4
PAST_LEN = 16384
PAGE_SIZE = 128

N_MIXERS = 2
N_ATTN_LAYERS = (DEPTH + 1) // 2
N_LRU_LAYERS = DEPTH // 2

N_HEADS = 8
N_KV_HEADS = 2
HEAD_DIM = D_MODEL // N_HEADS
ATTN_WIDTH = N_HEADS * HEAD_DIM
KV_WIDTH = N_KV_HEADS * HEAD_DIM
N_IDX_HEADS = 16
IDX_DIM = 64
TOPK_MAX = 256
ROPE_THETA = 500000.0
ROT_FRAC = 4
Q_BLOCK = 128
ATTN_SPLITS = (ATTN_WIDTH, KV_WIDTH, KV_WIDTH, N_IDX_HEADS * IDX_DIM, IDX_DIM, N_IDX_HEADS, ATTN_WIDTH)
IN_A = sum(ATTN_SPLITS)

LRU_WIDTH = D_MODEL
N_LRU_BLOCKS = 4
LRU_BLOCK = LRU_WIDTH // N_LRU_BLOCKS
CONV_W = 4
LRU_C = 8.0

EPS = 1e-6
POOL_SLACK = 1.25

kernel_name = "hybrid_dsa_rglru_adaln_step"

F32 = jnp.float32


def rmsnorm(x, g):
    xf = x.astype(F32)
    y = xf * lax.rsqrt(jnp.mean(xf * xf, axis=-1, keepdims=True) + EPS)
    return (y * g.astype(F32)).astype(x.dtype)


def modulate(x, c, g, aw, ab):
    m = jax.nn.silu(c) @ aw + ab
    shift, scale, gate = jnp.split(m, 3, axis=-1)
    h = rmsnorm(x, g) * (1 + scale[:, None]) + shift[:, None]
    return h, gate[:, None]


def rope(x, pos):
    d = x.shape[-1]
    r = d // ROT_FRAC
    half = r // 2
    inv = jnp.exp(-math.log(ROPE_THETA) * jnp.arange(half, dtype=F32) * 2.0 / r)
    ang = pos.astype(F32)[:, None] * inv[None, :]
    cos = jnp.cos(ang)[:, None, :]
    sin = jnp.sin(ang)[:, None, :]
    xf = x.astype(F32)
    x1 = xf[..., :half]
    x2 = xf[..., half:r]
    out = jnp.concatenate([x1 * cos - x2 * sin, x2 * cos + x1 * sin, xf[..., r:]], axis=-1)
    return out.astype(x.dtype)


def attn_project(h, pos, w_in, q_norm, k_norm):
    B, T, _ = h.shape
    z = h @ w_in
    offs = [int(o) for o in np.cumsum(ATTN_SPLITS)[:-1]]
    q, k, v, qi, ki, wi, g = jnp.split(z, offs, axis=-1)
    q = rope(rmsnorm(q.reshape(B, T, N_HEADS, HEAD_DIM), q_norm), pos)
    k = rope(rmsnorm(k.reshape(B, T, N_KV_HEADS, HEAD_DIM), k_norm), pos)
    v = v.reshape(B, T, N_KV_HEADS, HEAD_DIM)
    qi = rope(qi.reshape(B, T, N_IDX_HEADS, IDX_DIM), pos)
    ki = rope(ki.reshape(B, T, 1, IDX_DIM), pos)[:, :, 0]
    wi = wi * (N_IDX_HEADS ** -0.5 * IDX_DIM ** -0.5)
    return q, k, v, qi, ki, wi, g


def indexer_select(qi, wi, ki, q_pos, k_sel):
    dots = jnp.einsum('thd,ld->thl', qi.astype(F32), ki.astype(F32))
    score = jnp.einsum('th,thl->tl', wi.astype(F32), jax.nn.relu(dots))
    admissible = jnp.arange(ki.shape[0])[None, :] <= q_pos[:, None]
    score = jnp.where(admissible, score, -jnp.inf)
    _, idx = lax.top_k(score, k_sel)
    valid = idx <= q_pos[:, None]
    return idx, valid


def sparse_attend(q, k_sel, v_sel, valid):
    T = q.shape[0]
    qg = q.reshape(T, N_KV_HEADS, N_HEADS // N_KV_HEADS, HEAD_DIM).astype(F32)
    s = jnp.einsum('tkgd,tskd->tkgs', qg, k_sel.astype(F32)) * (HEAD_DIM ** -0.5)
    s = jnp.where(valid[:, None, None, :], s, -jnp.inf)
    p = jax.nn.softmax(s, axis=-1)
    o = jnp.einsum('tkgs,tskd->tkgd', p, v_sel.astype(F32))
    return o.reshape(T, ATTN_WIDTH).astype(q.dtype)


def attn_prompt(q, k, v, qi, ki, wi):
    B, S = q.shape[:2]
    k_sel = min(TOPK_MAX, S // 4)
    nb = S // Q_BLOCK
    pos_blocks = jnp.arange(S).reshape(nb, Q_BLOCK)

    def per_seq(args):
        q_b, k_b, v_b, qi_b, ki_b, wi_b = args

        def per_block(blk):
            qb, qib, wib, pos = blk
            idx, valid = indexer_select(qib, wib, ki_b, pos, k_sel)
            return sparse_attend(qb, k_b[idx], v_b[idx], valid)

        blocks = (q_b.reshape(nb, Q_BLOCK, N_HEADS, HEAD_DIM),
                  qi_b.reshape(nb, Q_BLOCK, N_IDX_HEADS, IDX_DIM),
                  wi_b.reshape(nb, Q_BLOCK, N_IDX_HEADS),
                  pos_blocks)
        return lax.map(per_block, blocks).reshape(S, ATTN_WIDTH)

    return lax.map(per_seq, (q, k, v, qi, ki, wi))


def attn_sample(q, k_new, v_new, qi, ki_new, wi, cache_k, cache_v, cache_idx_k, page_table, li):
    Bd, T = q.shape[:2]
    past = page_table.shape[1] * PAGE_SIZE
    L = past + T
    k_sel = min(TOPK_MAX, L // 4)
    ki_past = cache_idx_k[li, page_table].reshape(Bd, past, IDX_DIM)
    ki_all = jnp.concatenate([ki_past, ki_new.astype(ki_past.dtype)], axis=1)
    pos = past + jnp.arange(T)
    idx, valid = jax.vmap(lambda a, b, c_: indexer_select(a, b, c_, pos, k_sel))(qi, wi, ki_all)
    bidx = jnp.arange(Bd)[:, None, None]
    pidx = jnp.minimum(idx, past - 1)
    phys = page_table[bidx, pidx // PAGE_SIZE]
    slot = pidx % PAGE_SIZE
    nidx = jnp.clip(idx - past, 0, T - 1)
    in_past = (idx < past)[..., None, None]
    ks = jnp.where(in_past, cache_k[li, phys, slot], k_new[bidx, nidx])
    vs = jnp.where(in_past, cache_v[li, phys, slot], v_new[bidx, nidx])
    return jax.vmap(sparse_attend)(q, ks, vs, valid)


def causal_conv(xb, buf, w, b):
    xp = jnp.concatenate([buf.astype(xb.dtype), xb], axis=1)
    out = lax.conv_general_dilated(xp, w[:, None, :].astype(xb.dtype), window_strides=(1,), padding='VALID',
                                   dimension_numbers=('NWC', 'WIO', 'NWC'), feature_group_count=xb.shape[-1])
    return out + b, xp[:, -(CONV_W - 1):]


def rglru(xc, h0, w_a, b_a, w_x, b_x, lam):
    B, T, W = xc.shape
    xf = xc.astype(F32)
    xblk = xf.reshape(B, T, N_LRU_BLOCKS, LRU_BLOCK)
    r = jax.nn.sigmoid(jnp.einsum('btni,nij->btnj', xblk, w_a.astype(F32)).reshape(B, T, W) + b_a.astype(F32))
    i = jax.nn.sigmoid(jnp.einsum('btni,nij->btnj', xblk, w_x.astype(F32)).reshape(B, T, W) + b_x.astype(F32))
    log_a = LRU_C * r * jax.nn.log_sigmoid(lam.astype(F32))
    a = jnp.exp(log_a)
    bterm = jnp.sqrt(-jnp.expm1(2.0 * log_a)) * (i * xf)
    bterm = bterm.at[:, 0].add(a[:, 0] * h0.astype(F32))

    def comb(left, right):
        a_l, b_l = left
        a_r, b_r = right
        return a_l * a_r, a_r * b_l + b_r

    _, hs = lax.associative_scan(comb, (a, bterm), axis=1)
    return hs, hs[:, -1]


def lru_branch(h, buf, h0, w_in, conv_w, conv_b, w_a, b_a, w_x, b_x, lam, w_out):
    xb, g = jnp.split(h @ w_in, 2, axis=-1)
    xc, new_buf = causal_conv(xb, buf, conv_w, conv_b)
    hs, h_last = rglru(xc, h0, w_a, b_a, w_x, b_x, lam)
    out = (hs.astype(h.dtype) * jax.nn.silu(g)) @ w_out
    return out, new_buf, h_last.astype(h.dtype)


def setup_inputs(seed: int = 0) -> dict:
    key = jax.random.key(seed)
    ks = jax.random.split(key, 32)
    n_pages = PAST_LEN // PAGE_SIZE
    n_pool = int(math.ceil(POOL_SLACK * DEC_BATCH * n_pages))
    nrm = lambda k, shape, s=1.0: jax.random.normal(k, shape, F32) * s
    perm = jax.random.permutation(ks[0], n_pool)[: DEC_BATCH * n_pages]
    u = jax.random.uniform(ks[1], (N_LRU_LAYERS, LRU_WIDTH), F32, 0.9, 0.999)
    return {
        "x_prompt": nrm(ks[2], (BATCH, SEQ, D_MODEL)),
        "x_sample": nrm(ks[3], (DEC_BATCH, DEC_SEQ, D_MODEL)),
        "cache_k": nrm(ks[4], (N_ATTN_LAYERS, n_pool, PAGE_SIZE, N_KV_HEADS, HEAD_DIM)),
        "cache_v": nrm(ks[5], (N_ATTN_LAYERS, n_pool, PAGE_SIZE, N_KV_HEADS, HEAD_DIM)),
        "cache_idx_k": nrm(ks[6], (N_ATTN_LAYERS, n_pool, PAGE_SIZE, IDX_DIM)),
        "state_conv": nrm(ks[7], (N_LRU_LAYERS, DEC_BATCH, CONV_W - 1, LRU_WIDTH)),
        "state_h": nrm(ks[8], (N_LRU_LAYERS, DEC_BATCH, LRU_WIDTH), 0.5),
        "page_table": perm.reshape(DEC_BATCH, n_pages).astype(jnp.int32),
        "c_prompt": nrm(ks[9], (BATCH, D_MODEL)),
        "c_sample": nrm(ks[10], (DEC_BATCH, D_MODEL)),
        "norm_g": 1.0 + nrm(ks[11], (DEPTH, D_MODEL), 0.02),
        "ada_w": nrm(ks[12], (DEPTH, D_MODEL, 3 * D_MODEL), D_MODEL ** -0.5),
        "ada_b": nrm(ks[13], (DEPTH, 3 * D_MODEL), 0.02),
        "attn_w_in": nrm(ks[14], (N_ATTN_LAYERS, D_MODEL, IN_A), D_MODEL ** -0.5),
        "attn_q_norm": 1.0 + nrm(ks[15], (N_ATTN_LAYERS, HEAD_DIM), 0.02),
        "attn_k_norm": 1.0 + nrm(ks[16], (N_ATTN_LAYERS, HEAD_DIM), 0.02),
        "attn_w_out": nrm(ks[17], (N_ATTN_LAYERS, ATTN_WIDTH, D_MODEL), ATTN_WIDTH ** -0.5),
        "lru_w_in": nrm(ks[18], (N_LRU_LAYERS, D_MODEL, 2 * LRU_WIDTH), D_MODEL ** -0.5),
        "lru_conv_w": nrm(ks[19], (N_LRU_LAYERS, CONV_W, LRU_WIDTH), CONV_W ** -0.5),
        "lru_conv_b": nrm(ks[20], (N_LRU_LAYERS, LRU_WIDTH), 0.02),
        "lru_w_a": nrm(ks[21], (N_LRU_LAYERS, N_LRU_BLOCKS, LRU_BLOCK, LRU_BLOCK), LRU_BLOCK ** -0.5),
        "lru_b_a": nrm(ks[22], (N_LRU_LAYERS, LRU_WIDTH), 0.02),
        "lru_w_x": nrm(ks[23], (N_LRU_LAYERS, N_LRU_BLOCKS, LRU_BLOCK, LRU_BLOCK), LRU_BLOCK ** -0.5),
        "lru_b_x": nrm(ks[24], (N_LRU_LAYERS, LRU_WIDTH), 0.02),
        "lru_lam": jnp.log(u) - jnp.log1p(-u),
        "lru_w_out": nrm(ks[25], (N_LRU_LAYERS, LRU_WIDTH, D_MODEL), LRU_WIDTH ** -0.5),
    }


def reference(x_prompt, x_sample, cache_k, cache_v, cache_idx_k, state_conv, state_h, page_table,
              c_prompt, c_sample, norm_g, ada_w, ada_b, attn_w_in, attn_q_norm, attn_k_norm, attn_w_out,
              lru_w_in, lru_conv_w, lru_conv_b, lru_w_a, lru_b_a, lru_w_x, lru_b_x, lru_lam, lru_w_out):
    xp, xs = x_prompt, x_sample
    B, S, _ = xp.shape
    Bd, T, _ = xs.shape
    past = page_table.shape[1] * PAGE_SIZE
    pos_p = jnp.arange(S)
    pos_s = past + jnp.arange(T)
    kp_l, vp_l, ikp_l, ksm_l, vsm_l, iks_l = [], [], [], [], [], []
    cp_l, hp_l, cs_l, hs_l = [], [], [], []
    for layer in range(DEPTH):
        li = layer // N_MIXERS
        hp, gp = modulate(xp, c_prompt, norm_g[layer], ada_w[layer], ada_b[layer])
        hs, gs = modulate(xs, c_sample, norm_g[layer], ada_w[layer], ada_b[layer])
        if layer % N_MIXERS == 0:
            q, k, v, qi, ki, wi, g = attn_project(hp, pos_p, attn_w_in[li], attn_q_norm[li], attn_k_norm[li])
            o = attn_prompt(q, k, v, qi, ki, wi)
            xp = xp + gp * ((o * jax.nn.silu(g)) @ attn_w_out[li])
            kp_l.append(k); vp_l.append(v); ikp_l.append(ki)
            q2, k2, v2, qi2, ki2, wi2, g2 = attn_project(hs, pos_s, attn_w_in[li], attn_q_norm[li], attn_k_norm[li])
            o2 = attn_sample(q2, k2, v2, qi2, ki2, wi2, cache_k, cache_v, cache_idx_k, page_table, li)
            xs = xs + gs * ((o2 * jax.nn.silu(g2)) @ attn_w_out[li])
            ksm_l.append(k2); vsm_l.append(v2); iks_l.append(ki2)
        else:
            w = (lru_w_in[li], lru_conv_w[li], lru_conv_b[li], lru_w_a[li], lru_b_a[li],
                 lru_w_x[li], lru_b_x[li], lru_lam[li], lru_w_out[li])
            buf0 = jnp.zeros((B, CONV_W - 1, LRU_WIDTH), xp.dtype)
            h00 = jnp.zeros((B, LRU_WIDTH), F32)
            o, nbuf, hl = lru_branch(hp, buf0, h00, *w)
            xp = xp + gp * o
            cp_l.append(nbuf); hp_l.append(hl)
            o2, nbuf2, hl2 = lru_branch(hs, state_conv[li], state_h[li], *w)
            xs = xs + gs * o2
            cs_l.append(nbuf2); hs_l.append(hl2)
    k_prompt = jnp.stack(kp_l)
    v_prompt = jnp.stack(vp_l)
    ik_prompt = jnp.stack(ikp_l)
    k_sample = jnp.stack(ksm_l)
    v_sample = jnp.stack(vsm_l)
    ik_sample = jnp.stack(iks_l)
    conv_prompt = jnp.stack(cp_l)
    h_prompt = jnp.stack(hp_l)
    conv_sample = jnp.stack(cs_l)
    h_sample = jnp.stack(hs_l)
    return (xp, xs, k_prompt, v_prompt, ik_prompt, k_sample, v_sample, ik_sample,
            conv_prompt, h_prompt, conv_sample, h_sample)
```

```cpp
#include <hip/hip_runtime.h>
#include <stdint.h>
#include <stdio.h>

#define DUP_MASK 0
#ifndef N_LAUNCH_MODE
#define N_LAUNCH_MODE 1
#endif

#define LAS __attribute__((address_space(3)))
typedef _Float16 f16;
typedef _Float16 h8 __attribute__((ext_vector_type(8)));
typedef _Float16 h4 __attribute__((ext_vector_type(4)));
typedef float f32x2 __attribute__((ext_vector_type(2)));
typedef float f32x4 __attribute__((ext_vector_type(4)));
typedef float f32x16 __attribute__((ext_vector_type(16)));
typedef unsigned long long u64;
typedef unsigned u32x4 __attribute__((ext_vector_type(4)));

constexpr int D = 1024, NB = 16, SEQ = 2048, MP = NB * SEQ, DB = 32, DT = 4, MS = DB * DT, MT = MP + MS, MPAD = 33024;
constexpr int PAST = 16384, PAGE = 128, NPG = 128, LSP = 16400;
constexpr int NIN = 3840;
constexpr float EPS = 1e-6f;
constexpr int NTHR = 512;

constexpr size_t O_Y = 0, O_YS = O_Y + (size_t)MP * D, O_K = O_YS + (size_t)MS * D, O_V = O_K + (size_t)MP * 256, O_IK = O_V + (size_t)MP * 256,
                 O_KS = O_IK + (size_t)MP * 64, O_VS = O_KS + (size_t)MS * 256, O_IKS = O_VS + (size_t)MS * 256, O_CP = O_IKS + (size_t)MS * 64,
                 O_HP = O_CP + (size_t)NB * 3 * D, O_CS = O_HP + (size_t)NB * D, O_HS = O_CS + (size_t)DB * 3 * D, O_END = O_HS + (size_t)DB * D;

constexpr size_t al256(size_t x) { return (x + 255) & ~(size_t)255; }
constexpr size_t WS_REG = (size_t)MPAD * D * 2;
constexpr size_t WS_CTL = 0, WS_WIN = 65536, WS_WO0 = WS_WIN + al256((size_t)NIN * D * 2), WS_WLIN = WS_WO0 + (size_t)D * D * 2, WS_WG = WS_WLIN + (size_t)2 * D * D * 2,
                 WS_WLO = WS_WG + (size_t)2048 * 256 * 2, WS_ADA = WS_WLO + (size_t)D * D * 2, WS_R0 = WS_ADA + al256((size_t)2 * 48 * 3072 * 4),
                 WS_R1 = WS_R0 + WS_REG, WS_R2 = WS_R1 + WS_REG, WS_R3 = WS_R2 + WS_REG,
                 WS_H = WS_R0, WS_LA = WS_R0, WS_Q = WS_R1, WS_XB = WS_R1, WS_QI = WS_R2, WS_AO = WS_R2, WS_XC = WS_R2, WS_U = WS_R2, WS_SG = WS_R3, WS_G1 = WS_R3,
                 WS_KH = WS_R3 + WS_REG, WS_VT = WS_KH + (size_t)MPAD * 256 * 2, WS_KIH = WS_VT + (size_t)NB * 2 * 128 * SEQ * 2,
                 WS_WI = WS_KIH + (size_t)MPAD * 64 * 2, WS_MASK = WS_WI + (size_t)MPAD * 16 * 4, WS_SCS = WS_MASK + (size_t)MP * 64 * 4,
                 WS_X1 = WS_SCS + al256((size_t)MS * LSP * 4), WS_TOT = WS_X1 + (size_t)MPAD * D * 4,
                 WS_HS = WS_TOT + (size_t)NB * 16 * D * 2 * 4, WS_AOS = WS_HS + 262144, WS_XCS = WS_AOS + 262144, WS_US = WS_XCS + 262144, WS_ROPE = WS_US + 262144, WS_LS = WS_ROPE + al256((size_t)(SEQ + DT) * 24 * 2 * 4), WS_XBT = WS_LS + 4096, WS_SSP = WS_XBT + (size_t)(MP / 256) * 3 * D * 4, WS_SSPS = WS_SSP + (size_t)MP * 16 * 4, WS_SW = WS_SSPS + (size_t)MS * 64 * 4,
                 WS_SHS = WS_SW + (size_t)48 * 2 * D * 4, WS_END = WS_SHS + 262144;
constexpr size_t WS_XCH = WS_TOT;

constexpr int LDS_STAGE = 131072, LDS_AUX = 131072, LDS_BARW = 147456, LDS_BYTES = 147472;

__constant__ double INV32[16] = {1.0, 0.4403666026717805, 0.1939227447486858, 0.08539710028576561, 0.03760603093086394, 0.016560440080994443, 0.007292664737217109,
                                 0.0032114459947525913, 0.0014142135623730955, 0.0006227724219145962, 0.00027424817567620724, 0.00012076973741146502,
                                 5.318295896944988e-05, 2.3419998961409345e-05, 1.0313385377212461e-05, 4.541670480607871e-06};
__constant__ double INV16[8] = {1.0, 0.1939227447486858, 0.03760603093086394, 0.007292664737217109, 0.0014142135623730955, 0.00027424817567620724,
                                5.318295896944988e-05, 1.0313385377212461e-05};

struct Params {
    const float *x_p, *x_s, *cache_k, *cache_v, *cache_ik, *st_conv, *st_h;
    const int* page_table;
    const float *c_p, *c_s, *norm_g, *ada_w, *ada_b, *w_in, *q_norm, *k_norm, *w_out0, *lw_in, *conv_w, *conv_b, *w_a, *b_a, *w_x, *b_x, *lam, *lw_out;
    float* out;
    unsigned char* ws;
    long ph_lo, ph_hi;
};

typedef const Params __attribute__((address_space(4))) CParams;

#define XB_TMO      128
#define XB_XCNT(j)  (256  + 64 * (j))
#define XB_XSUB(j)  (1280 + 64 * (j))
#define XB_XGEN(j)  (2304 + 64 * (j))
#define XB_TOP      3328
#define XB_TOPGEN   3392
#define XCD_BAR_WORDS 3456
#define XB_SPIN_CAP (1u << 22)

__device__ __forceinline__ unsigned xb_ld(unsigned* p)              { return __hip_atomic_load(p, __ATOMIC_RELAXED, __HIP_MEMORY_SCOPE_AGENT); }
__device__ __forceinline__ unsigned xb_add(unsigned* p, unsigned v) { return __hip_atomic_fetch_add(p, v, __ATOMIC_RELAXED, __HIP_MEMORY_SCOPE_AGENT); }
__device__ __forceinline__ unsigned xb_xcc_id() { return (unsigned)__builtin_amdgcn_s_getreg((3 << 11) | 20) & 0xFu; }
#define XB_SPIN(cond, bar) do { unsigned _sp = 0; while (cond) { __builtin_amdgcn_s_sleep(1); \
    if ((++_sp & 255u) == 0u) { if (xb_ld(&(bar)[XB_TMO])) break; if (_sp > XB_SPIN_CAP) { atomicAdd(&(bar)[XB_TMO], 1u); break; } } } } while (0)

struct XcdBarrier { unsigned* bar; unsigned x; volatile LAS unsigned* st; };

__device__ __forceinline__ XcdBarrier xcd_barrier_post(unsigned* bar, volatile LAS unsigned* st) {
    XcdBarrier b; b.bar = bar; b.x = xb_xcc_id(); b.st = st;
    if (threadIdx.x == 0) (void)xb_add(&bar[XB_XCNT(b.x)], 1u);
    return b;
}
__device__ __forceinline__ void xcd_barrier_complete(unsigned* bar, unsigned x, unsigned& nloc, unsigned& nx) {
    const unsigned G = gridDim.x * gridDim.y * gridDim.z;
    unsigned sum, cnt, mine, sp = 0u;
    for (;;) {
        sum = 0u; cnt = 0u; mine = 0u;
#pragma unroll
        for (unsigned j = 0; j < 16; ++j) { const unsigned c = xb_ld(&bar[XB_XCNT(j)]); sum += c; cnt += (c > 0u) ? 1u : 0u; mine = (j == x) ? c : mine; }
        if (sum == G) break;
        __builtin_amdgcn_s_sleep(1);
        if ((++sp & 255u) == 0u) { if (xb_ld(&bar[XB_TMO])) break; if (sp > XB_SPIN_CAP) { atomicAdd(&bar[XB_TMO], 1u); break; } }
    }
    nloc = mine > 0u ? mine : 1u; nx = cnt > 0u ? cnt : 1u;
}
__device__ __forceinline__ void xcd_barrier(const XcdBarrier& b) {
    asm volatile("s_waitcnt vmcnt(0)" ::: "memory");
    __syncthreads();
    if (threadIdx.x == 0) {
        unsigned* bar = b.bar;
        __builtin_amdgcn_s_waitcnt(0);
        unsigned nloc = b.st[0], nx = b.st[1];
        if (nloc == 0u) { xcd_barrier_complete(bar, b.x, nloc, nx); b.st[0] = nloc; b.st[1] = nx; }
        const unsigned old = xb_add(&bar[XB_XSUB(b.x)], 1u);
        const unsigned gen = old / nloc;
        if (old + 1u == (gen + 1u) * nloc) {
            __builtin_amdgcn_fence(__ATOMIC_RELEASE, "agent");
            asm volatile("s_waitcnt vmcnt(0)" ::: "memory");
            const unsigned og = xb_add(&bar[XB_TOP], 1u);
            const unsigned tg = og / nx;
            if (og + 1u == (tg + 1u) * nx) xb_add(&bar[XB_TOPGEN], 1u);
            else XB_SPIN(xb_ld(&bar[XB_TOPGEN]) == tg, bar);
            __builtin_amdgcn_fence(__ATOMIC_ACQUIRE, "agent");
            xb_add(&bar[XB_XGEN(b.x)], 1u);
            asm volatile("s_waitcnt vmcnt(0)" ::: "memory");
        } else {
            XB_SPIN(xb_ld(&bar[XB_XGEN(b.x)]) == gen, bar);
            __builtin_amdgcn_fence(__ATOMIC_ACQUIRE, "agent");
            asm volatile("s_waitcnt vmcnt(0)" ::: "memory");
        }
    }
    __syncthreads();
}

#define WSYNC() asm volatile("s_waitcnt lgkmcnt(0)" ::: "memory")
__device__ __forceinline__ int tid_fresh_(int wv_s) { int l; asm volatile("v_mbcnt_lo_u32_b32 %0, -1, 0\n\tv_mbcnt_hi_u32_b32 %0, -1, %0" : "=v"(l)); return wv_s * 64 + l; }
#define tid_fresh() tid_fresh_(wv_s)
__device__ __forceinline__ float wave_sum(float v) {
#pragma unroll
    for (int o = 32; o > 0; o >>= 1) v += __shfl_xor(v, o);
    return v;
}
__device__ __forceinline__ float wave_max(float v) {
#pragma unroll
    for (int o = 32; o > 0; o >>= 1) v = fmaxf(v, __shfl_xor(v, o));
    return v;
}
__device__ __forceinline__ float wave_min(float v) {
#pragma unroll
    for (int o = 32; o > 0; o >>= 1) v = fminf(v, __shfl_xor(v, o));
    return v;
}
__device__ __forceinline__ float relu_f(float x) { const int b = __builtin_bit_cast(int, x); return __builtin_bit_cast(float, b > 0 ? b : 0); }
__device__ __forceinline__ float silu_f(float v) { return v * __builtin_amdgcn_rcpf(1.f + __expf(-v)); }
__device__ __forceinline__ float sigmoid_f(float v) { return __builtin_amdgcn_rcpf(1.f + __expf(-v)); }
__device__ __forceinline__ h4 to_h4(f32x4 v) { h4 r; r[0] = (f16)v[0]; r[1] = (f16)v[1]; r[2] = (f16)v[2]; r[3] = (f16)v[3]; return r; }
typedef _Float16 h2v __attribute__((ext_vector_type(2)));
__device__ __forceinline__ unsigned pack_lb(float l, float b) { h2v t; t[0] = (f16)(l * 64.f); t[1] = (f16)b; return __builtin_bit_cast(unsigned, t); }
__device__ __forceinline__ void unpack_lb(unsigned w, float& a, float& b) { const h2v t = __builtin_bit_cast(h2v, w); a = __expf((float)t[0] * 0.015625f); b = (float)t[1]; }
__device__ __forceinline__ void rope_cs(int pos, double inv, float& c, float& sn) { double rev = (double)pos * inv * 0.15915494309189535; rev -= floor(rev); const float rf = (float)rev; c = __builtin_amdgcn_cosf(rf); sn = __builtin_amdgcn_sinf(rf); }
__device__ __forceinline__ const float* rope_row(const float* ROPE, int pos, int f0) { const int idx = pos < SEQ ? pos : SEQ + (pos - PAST); return ROPE + ((size_t)idx * 24 + f0) * 2; }
__device__ __forceinline__ int row_pos(int row) { return row < MP ? (row & (SEQ - 1)) : PAST + ((row - MP) & 3); }
__device__ __forceinline__ int row_arow(int row) { return row < MP ? (row >> 11) : 16 + ((row - MP) >> 2); }

namespace pg {
constexpr int BM = 256, BK = 64, HALF = 128, HTB = HALF * BK * 2, STAGE_BYTES = 8 * HTB, NXCD = 8, WGM = 8;
__host__ __device__ __forceinline__ int lds_byte(int r, int c) { const int st = (r >> 4) * 2 + (c >> 5), rr = r & 15, cc = c & 31, ob = rr * 64 + cc * 2; return st * 1024 + (ob ^ (((ob >> 9) & 1) << 5)); }
__host__ __device__ __forceinline__ void stage_rc(int b, int& R, int& C) { const int st = b / 1024, sb = b % 1024, swz = sb ^ (((sb >> 9) & 1) << 5); R = (st >> 1) * 16 + swz / 64; C = (st & 1) * 32 + (swz % 64) / 2; }

__host__ __device__ __forceinline__ int perm32(int rho) { const int n = rho >> 4, i = rho & 15; return 8 * (i >> 2) + 4 * n + (i & 3); }
struct Unit { int pm, pn; long aoff, boff; };
struct Gemm { const f16* A; const f16* Bt; int lda, ldb, K; };

template <class MAP> struct GridOrder {
    int nM, nN, nwg, G, c; MAP map;
    __device__ void init(int nM_, int nN_, int G_, int c_, MAP m) { nM = nM_; nN = nN_; nwg = nM * nN; G = G_; c = c_; map = m; }
    __device__ bool next(int i, Unit& u) const {
        const long L = (long)i * G + c; if (L >= nwg) return false;
        int wgid = (int)L; { const int q = nwg / NXCD, r = nwg % NXCD, xcd = wgid % NXCD, off = wgid / NXCD; wgid = (xcd < r ? xcd * (q + 1) : r * (q + 1) + (xcd - r) * q) + off; }
        const int nig = WGM * nN, gid = wgid / nig, fm = gid * WGM, gsz = (nM - fm) < WGM ? (nM - fm) : WGM;
        u.pm = fm + ((wgid % nig) % gsz); u.pn = (wgid % nig) / gsz; map(u); return true;
    }
};

template <class Epi, class Sched>
__device__ __forceinline__ void gemm_phase(LAS unsigned char* lds, const Gemm g, const Sched& S, const Epi& E, const int wv_s) {
    const int tid = tid_fresh(), wid = __builtin_amdgcn_readfirstlane(tid >> 6), lane = tid & 63, wr = wid >> 2, wc = wid & 3, fr = lane & 15, fq = lane >> 4;
    const int K = g.K, nt = K / BK;
    unsigned voffA[2], voffB[2];
#pragma unroll
    for (int i = 0; i < 2; ++i) { int R, C; stage_rc(tid * 16 + i * 8192, R, C); const int Rb = (R & ~31) + perm32(R & 31);
        voffA[i] = (unsigned)(R * g.lda + C) * 2u; voffB[i] = (unsigned)(Rb * g.ldb + C) * 2u; }
    const size_t kstep = (size_t)(BK * 2);
    const size_t hstepA = (size_t)HALF * g.lda * 2, hstepB = (size_t)HALF * g.ldb * 2;
    const unsigned ldsw = (unsigned)wid * 1024u;
    const int aoff = lds_byte(wr * 64 + fr, fq * 8), boff = lds_byte(wc * 32 + fr, fq * 8);
#define PG_SA(b, h) (((b) * 2 + (h)) * HTB)
#define PG_SB(b, h) ((4 + (b) * 2 + (h)) * HTB)
#define PG_STAGE(bufoff, gbase, voff) do { _Pragma("unroll") for (int _i = 0; _i < 2; ++_i) \
        __builtin_amdgcn_global_load_lds((const unsigned*)((const char*)(gbase) + (voff)[_i]), (LAS unsigned*)(lds + (bufoff) + ldsw + _i * 8192), 16, 0, 0); } while (0)
#define PG_LDA(dst, b, h) do { _Pragma("unroll") for (int m = 0; m < 4; ++m) _Pragma("unroll") for (int k = 0; k < 2; ++k) dst[m][k] = *(const LAS h8*)(lds + PG_SA(b, h) + aoff + m * 2048 + k * 1024); } while (0)
#define PG_LDB(dst, b, h) do { _Pragma("unroll") for (int n = 0; n < 2; ++n) _Pragma("unroll") for (int k = 0; k < 2; ++k) dst[n][k] = *(const LAS h8*)(lds + PG_SB(b, h) + boff + n * 2048 + k * 1024); } while (0)
#define PG_MMA(ai, bj, At, Bt) do { __builtin_amdgcn_s_setprio(1); _Pragma("unroll") for (int m = 0; m < 4; ++m) _Pragma("unroll") for (int n = 0; n < 2; ++n) _Pragma("unroll") for (int k = 0; k < 2; ++k) \
        acc[ai][bj][m][n] = __builtin_amdgcn_mfma_f32_16x16x32_f16(Bt[n][k], At[m][k], acc[ai][bj][m][n], 0, 0, 0); __builtin_amdgcn_s_setprio(0); } while (0)
#define PG_WAIT_V(n) asm volatile("s_waitcnt vmcnt(" #n ")" ::: "memory")
#define PG_WAIT_L(n) asm volatile("s_waitcnt lgkmcnt(" #n ")" ::: "memory")
#define PG_BAR __builtin_amdgcn_s_barrier()
#define PG_SCHED __builtin_amdgcn_sched_barrier(0)
    Unit cur, nxt; int ui = 0;
    if (!S.next(0, cur)) return;
    f32x4 acc[2][2][4][2];
#pragma unroll
    for (int a = 0; a < 2; ++a)
#pragma unroll
        for (int b = 0; b < 2; ++b)
#pragma unroll
            for (int m = 0; m < 4; ++m)
#pragma unroll
                for (int n = 0; n < 2; ++n) acc[a][b][m][n] = (f32x4){0.f, 0.f, 0.f, 0.f};
    h8 At[4][2], B0[2][2], B1[2][2];
    const char* cA = (const char*)g.A + (size_t)cur.aoff * 2; const char* cB = (const char*)g.Bt + (size_t)cur.boff * 2;
    PG_STAGE(PG_SB(0, 0), cB, voffB); PG_STAGE(PG_SA(0, 0), cA, voffA); PG_STAGE(PG_SB(0, 1), cB + hstepB, voffB); PG_STAGE(PG_SA(0, 1), cA + hstepA, voffA);
    if (wr == 1) PG_BAR;
    PG_WAIT_V(4); PG_BAR;
    PG_STAGE(PG_SB(1, 0), cB + kstep, voffB); PG_STAGE(PG_SA(1, 0), cA + kstep, voffA); PG_STAGE(PG_SB(1, 1), cB + hstepB + kstep, voffB);
    PG_WAIT_V(6); PG_BAR;
    for (;;) {
        const bool has_next = S.next(ui + 1, nxt);
        const char* nA = has_next ? (const char*)g.A + (size_t)nxt.aoff * 2 : cA; const char* nB = has_next ? (const char*)g.Bt + (size_t)nxt.boff * 2 : cB;
#pragma nounroll
        for (int t = 0; t < nt; t += 2) {
            const bool last = (t == nt - 2);
            const char* a1 = cA + (size_t)(t + 1) * kstep;
            const char* a2 = last ? nA : cA + (size_t)(t + 2) * kstep; const char* b2 = last ? nB : cB + (size_t)(t + 2) * kstep;
            const char* a3 = a2 + kstep; const char* b3 = b2 + kstep;
            PG_LDB(B0, 0, 0); PG_SCHED; PG_LDA(At, 0, 0); PG_STAGE(PG_SA(1, 1), a1 + hstepA, voffA);
            PG_WAIT_L(8); PG_BAR; PG_WAIT_L(0); PG_MMA(0, 0, At, B0); PG_BAR; PG_SCHED;
            PG_LDB(B1, 0, 1); PG_STAGE(PG_SB(0, 0), b2, voffB);
            PG_BAR; PG_WAIT_L(0); PG_MMA(0, 1, At, B1); PG_BAR;
            PG_LDA(At, 0, 1); PG_STAGE(PG_SA(0, 0), a2, voffA);
            PG_BAR; PG_WAIT_L(0); PG_MMA(1, 0, At, B0); PG_BAR; PG_SCHED;
            PG_STAGE(PG_SB(0, 1), b2 + hstepB, voffB);
            PG_WAIT_V(6); PG_BAR; PG_MMA(1, 1, At, B1); PG_BAR;
            PG_LDB(B0, 1, 0); PG_SCHED; PG_LDA(At, 1, 0); PG_STAGE(PG_SA(0, 1), a2 + hstepA, voffA);
            PG_WAIT_L(8); PG_BAR; PG_WAIT_L(0); PG_MMA(0, 0, At, B0); PG_BAR; PG_SCHED;
            PG_LDB(B1, 1, 1); PG_STAGE(PG_SB(1, 0), b3, voffB);
            PG_BAR; PG_WAIT_L(0); PG_MMA(0, 1, At, B1); PG_BAR;
            PG_LDA(At, 1, 1); PG_STAGE(PG_SA(1, 0), a3, voffA);
            PG_BAR; PG_WAIT_L(0); PG_MMA(1, 0, At, B0); PG_BAR; PG_SCHED;
            PG_STAGE(PG_SB(1, 1), b3 + hstepB, voffB);
            PG_WAIT_V(6); PG_BAR; PG_MMA(1, 1, At, B1); PG_BAR;
        }
        E(acc, cur, wr, wc, fr, fq);
        if (!has_next) break;
#pragma unroll
        for (int a = 0; a < 2; ++a)
#pragma unroll
            for (int b = 0; b < 2; ++b)
#pragma unroll
                for (int m = 0; m < 4; ++m)
#pragma unroll
                    for (int n = 0; n < 2; ++n) acc[a][b][m][n] = (f32x4){0.f, 0.f, 0.f, 0.f};
        cur = nxt; cA = nA; cB = nB; ++ui;
    }
    PG_WAIT_V(0);
    if (wr == 0) PG_BAR;
    PG_BAR;
#undef PG_SA
#undef PG_SB
#undef PG_STAGE
#undef PG_LDA
#undef PG_LDB
#undef PG_MMA
#undef PG_WAIT_V
#undef PG_WAIT_L
#undef PG_BAR
#undef PG_SCHED
}
}

struct MapFull { int lda, ldb; __device__ void operator()(pg::Unit& u) const { u.aoff = (long)u.pm * 256 * lda; u.boff = (long)u.pn * 256 * ldb; } };
struct MapGates { __device__ void operator()(pg::Unit& u) const { u.aoff = (long)u.pm * 256 * D + (u.pn >> 1) * 256; u.boff = (long)u.pn * 256 * 256; } };

__device__ __forceinline__ size_t as16_off(int rs, int k) { return ((size_t)(((k >> 5) * 8 + (rs >> 4)) * 64 + ((k >> 3) & 3) * 16 + (rs & 15))) * 8 + (k & 7); }

__device__ __forceinline__ h8 to_h8(f32x4 a, f32x4 b) { h8 r; r[0] = (f16)a[0]; r[1] = (f16)a[1]; r[2] = (f16)a[2]; r[3] = (f16)a[3]; r[4] = (f16)b[0]; r[5] = (f16)b[1]; r[6] = (f16)b[2]; r[7] = (f16)b[3]; return r; }
__device__ __forceinline__ f32x4 silu4(f32x4 v) { f32x4 s; s[0] = silu_f(v[0]); s[1] = silu_f(v[1]); s[2] = silu_f(v[2]); s[3] = silu_f(v[3]); return s; }
template <class Emit> struct EpiMain {
    Emit em;
    __device__ __forceinline__ void operator()(const f32x4 (&acc)[2][2][4][2], const pg::Unit& u, int wr, int wc, int fr, int fq) const {
        const int pn = __builtin_amdgcn_readfirstlane(u.pn);
#pragma unroll
        for (int ai = 0; ai < 2; ++ai)
#pragma unroll
            for (int m = 0; m < 4; ++m) {
                const int row = u.pm * 256 + ai * 128 + wr * 64 + m * 16 + fr;
#pragma unroll
                for (int bj = 0; bj < 2; ++bj) em.template emit8<false>(pn, row, u.pn * 256 + bj * 128 + wc * 32 + 8 * fq, acc[ai][bj][m][0], acc[ai][bj][m][1]);
            }
    }
};

struct EmitNull { template <bool SMP> __device__ __forceinline__ void emit8(int pn, int row, int col, const f32x4 v, const f32x4 w) const { if (v[0] == 1.2345e30f && w[0] == 1.f) *(volatile int*)nullptr = row + col; } };
struct EmitInproj {
    f16 *Q, *QI, *SG, *VT; float* WI; float* out;
    template <bool SMP> __device__ __forceinline__ void emit(int pn, int row, int col, const f32x4 v) const {
        constexpr bool smp = SMP; const int rs = row - MP;
        if (pn < 4) { *(h4*)(Q + (size_t)row * D + col) = to_h4(v); }
        else if (pn == 4) { float* dst = smp ? out + O_KS + (size_t)rs * 256 + (col - 1024) : out + O_K + (size_t)row * 256 + (col - 1024); *(f32x4*)dst = v; }
        else if (pn == 5) {
            const int c5 = col - 1280;
            float* dst = smp ? out + O_VS + (size_t)rs * 256 + c5 : out + O_V + (size_t)row * 256 + c5; *(f32x4*)dst = v;
            if (!smp) { const int b = row >> 11, pos = row & (SEQ - 1), kvh = c5 >> 7, d = c5 & 127;
                const int pk = pos & 15, pp = (pos & ~15) | (pk < 4 ? pk : (pk < 8 ? pk + 4 : (pk < 12 ? pk - 4 : pk)));
                f16* vt = VT + ((size_t)(b * 2 + kvh) * 128 + d) * SEQ + pp;
                vt[0] = (f16)v[0]; vt[SEQ] = (f16)v[1]; vt[2 * SEQ] = (f16)v[2]; vt[3 * SEQ] = (f16)v[3]; }
        }
        else if (pn < 10) { *(h4*)(QI + (size_t)row * D + (col - 1536)) = to_h4(v); }
        else if (pn < 14) { *(h4*)(SG + (size_t)row * D + (col - 2560)) = to_h4(v); }
        else { const int c14 = col - 3584;
            if (c14 < 64) { float* dst = smp ? out + O_IKS + (size_t)rs * 64 + c14 : out + O_IK + (size_t)row * 64 + c14; *(f32x4*)dst = v; }
            else if (c14 < 80) { *(f32x4*)(WI + (size_t)row * 16 + (c14 - 64)) = v * 0.03125f; } }
    }
    template <bool SMP> __device__ __forceinline__ void emit8(int pn, int row, int col, const f32x4 v, const f32x4 w) const {
        if (pn < 4) { *(h8*)(Q + (size_t)row * D + col) = to_h8(v, w); }
        else if (pn >= 6 && pn < 10) { *(h8*)(QI + (size_t)row * D + (col - 1536)) = to_h8(v, w); }
        else if (pn >= 10 && pn < 14) { *(h8*)(SG + (size_t)row * D + (col - 2560)) = to_h8(v, w); }
        else { emit<SMP>(pn, row, col, v); emit<SMP>(pn, row, col + 4, w); }
    }
};

struct EmitResid {
    const float *xa, *xb; const float* gate; float *oa, *ob;
    template <bool SMP> __device__ __forceinline__ void emit(int pn, int row, int col, const f32x4 v) const {
        constexpr bool smp = SMP; const int rs = row - MP;
        const f32x4 gv = *(const f32x4*)(gate + (size_t)row_arow(row) * 3072 + 2048 + col);
        const f32x4 xv = smp ? *(const f32x4*)(xb + (size_t)rs * D + col) : *(const f32x4*)(xa + (size_t)row * D + col);
        float* dst = smp ? ob + (size_t)rs * D + col : oa + (size_t)row * D + col;
        *(f32x4*)dst = xv + gv * v;
    }
    template <bool SMP> __device__ __forceinline__ void emit8(int pn, int row, int col, const f32x4 v, const f32x4 w) const { emit<SMP>(pn, row, col, v); emit<SMP>(pn, row, col + 4, w); }
};

struct EpiResidH {
    const float* x; const float *ada0, *ada1, *ng1; float* X1; f16* Hn; float* SSP;
    __device__ __forceinline__ void operator()(const f32x4 (&acc)[2][2][4][2], const pg::Unit& u, int wr, int wc, int fr, int fq) const {
        const int pn = __builtin_amdgcn_readfirstlane(u.pn), pm = __builtin_amdgcn_readfirstlane(u.pm);
        const float *a0 = ada0 + (size_t)(pm >> 3) * 3072 + 2048, *a1 = ada1 + (size_t)(pm >> 3) * 3072 + 1024;
        f32x4 gt[2][2], ff[2][2];
#pragma unroll
        for (int bj = 0; bj < 2; ++bj)
#pragma unroll
            for (int n = 0; n < 2; ++n) { const int c = pn * 256 + bj * 128 + wc * 32 + 8 * fq + 4 * n;
                gt[bj][n] = *(const f32x4*)(a0 + c); ff[bj][n] = *(const f32x4*)(ng1 + c) * (*(const f32x4*)(a1 + c) + 1.f); }
#pragma unroll
        for (int ai = 0; ai < 2; ++ai)
#pragma unroll
            for (int m = 0; m < 4; ++m) {
                const int row = pm * 256 + ai * 128 + wr * 64 + m * 16 + fr;
                float ss = 0.f;
#pragma unroll
                for (int bj = 0; bj < 2; ++bj) { const int c = pn * 256 + bj * 128 + wc * 32 + 8 * fq;
                    const float* xr = x + (size_t)row * D + c;
                    const f32x4 y0 = *(const f32x4*)xr + gt[bj][0] * acc[ai][bj][m][0], y1 = *(const f32x4*)(xr + 4) + gt[bj][1] * acc[ai][bj][m][1];
                    float* d = X1 + (size_t)row * D + c; *(f32x4*)d = y0; *(f32x4*)(d + 4) = y1;
                    *(h8*)(Hn + (size_t)row * D + c) = to_h8(y0 * ff[bj][0], y1 * ff[bj][1]);
                    ss += y0[0] * y0[0] + y0[1] * y0[1] + y0[2] * y0[2] + y0[3] * y0[3] + y1[0] * y1[0] + y1[1] * y1[1] + y1[2] * y1[2] + y1[3] * y1[3]; }
                ss += __shfl_xor(ss, 16); ss += __shfl_xor(ss, 32);
                if (fq == 0) SSP[(size_t)row * 16 + pn * 4 + wc] = ss;
            }
    }
};
struct EmitResidHS {
    const float* xs; const float *ada0, *ada1, *ng1; float* X1s; f16* HS; float* SSPS;
    template <bool SMP> __device__ __forceinline__ void emit(int pn, int row, int col, const f32x4 v) const {
        const int rs = row - MP, ar = 16 + (rs >> 2);
        const f32x4 y = *(const f32x4*)(xs + (size_t)rs * D + col) + *(const f32x4*)(ada0 + (size_t)ar * 3072 + 2048 + col) * v;
        *(f32x4*)(X1s + (size_t)rs * D + col) = y;
        const f32x4 f = *(const f32x4*)(ng1 + col) * (*(const f32x4*)(ada1 + (size_t)ar * 3072 + 1024 + col) + 1.f);
        *(h4*)(HS + as16_off(rs, col)) = to_h4(y * f);
        float ss = y[0] * y[0] + y[1] * y[1] + y[2] * y[2] + y[3] * y[3];
        ss += __shfl_xor(ss, 16); ss += __shfl_xor(ss, 32);
        if ((col & 15) == 0) SSPS[(size_t)rs * 64 + (col >> 4)] = ss;
    }
};
struct EmitSW {
    float* SW;
    template <bool SMP> __device__ __forceinline__ void emit(int pn, int row, int col, const f32x4 v) const { const int rs = row - MP; if (rs < 48) *(f32x4*)(SW + (size_t)rs * 2 * D + col) = v; }
};

struct EmitLruIn {
    f16* XB; f16* G1; const float *SSPS, *SW;
    template <bool SMP> __device__ __forceinline__ void emit(int pn, int row, int col, const f32x4 v0) const {
        const int rs = row - MP;
        f32x4 t = (f32x4){0.f, 0.f, 0.f, 0.f};
#pragma unroll
        for (int i = 0; i < 16; ++i) t += *(const f32x4*)(SSPS + (size_t)rs * 64 + 4 * i);
        const float rstd = rsqrtf(((t[0] + t[1]) + (t[2] + t[3])) * (1.f / D) + EPS);
        const f32x4 v = v0 * rstd + *(const f32x4*)(SW + (size_t)(16 + (rs >> 2)) * 2 * D + col);
        if (pn < 4) { *(h4*)(XB + (size_t)row * D + col) = to_h4(v); }
        else { *(h4*)(G1 + (size_t)row * D + (col - 1024)) = to_h4(silu4(v)); }
    }
    template <bool SMP> __device__ __forceinline__ void emit8(int pn, int row, int col, const f32x4 v, const f32x4 w) const {
        if (pn < 4) { *(h8*)(XB + (size_t)row * D + col) = to_h8(v, w); }
        else { *(h8*)(G1 + (size_t)row * D + (col - 1024)) = to_h8(silu4(v), silu4(w)); }
    }
};

#define DPP_ROW_ROR(n) (0x120 + (n))
#define dpp_ror_f(src, n) __int_as_float(__builtin_amdgcn_update_dpp(__float_as_int(src), __float_as_int(src), DPP_ROW_ROR(n), 0xf, 0xf, false))
struct EpiLruIn {
    EmitLruIn em; f16* XC; float* XCH; float* XBT; float* out; const float *cw, *cb; LAS unsigned char* lds; const float *SSP, *SW;
    __device__ __forceinline__ void operator()(f32x4 (&acc)[2][2][4][2], const pg::Unit& u, int wr, int wc, int fr, int fq) const {
        const int pn = __builtin_amdgcn_readfirstlane(u.pn), pm = __builtin_amdgcn_readfirstlane(u.pm);
        {
            f32x4 sw[2][2];
#pragma unroll
            for (int bj = 0; bj < 2; ++bj)
#pragma unroll
                for (int n = 0; n < 2; ++n) sw[bj][n] = *(const f32x4*)(SW + (size_t)(pm >> 3) * 2 * D + pn * 256 + bj * 128 + wc * 32 + 8 * fq + 4 * n);
#pragma unroll
            for (int ai = 0; ai < 2; ++ai)
#pragma unroll
                for (int m = 0; m < 4; ++m) {
                    const float* sp = SSP + (size_t)(pm * 256 + ai * 128 + wr * 64 + m * 16 + fr) * 16;
                    const f32x4 t = (*(const f32x4*)sp + *(const f32x4*)(sp + 4)) + (*(const f32x4*)(sp + 8) + *(const f32x4*)(sp + 12));
                    const float rstd = rsqrtf(((t[0] + t[1]) + (t[2] + t[3])) * (1.f / D) + EPS);
#pragma unroll
                    for (int bj = 0; bj < 2; ++bj)
#pragma unroll
                        for (int n = 0; n < 2; ++n) acc[ai][bj][m][n] = acc[ai][bj][m][n] * rstd + sw[bj][n];
                }
        }
        if (pn >= 4) {
#pragma unroll
            for (int ai = 0; ai < 2; ++ai)
#pragma unroll
                for (int m = 0; m < 4; ++m) {
                    const int row = pm * 256 + ai * 128 + wr * 64 + m * 16 + fr;
#pragma unroll
                    for (int bj = 0; bj < 2; ++bj) em.template emit8<false>(pn, row, pn * 256 + bj * 128 + wc * 32 + 8 * fq, acc[ai][bj][m][0], acc[ai][bj][m][1]);
                }
            return;
        }
        LAS float* T = (LAS float*)(lds + LDS_AUX);
        const int lc = wc * 32 + 8 * fq;
        if (fr >= 13) {
#pragma unroll
            for (int ai = 0; ai < 2; ++ai)
#pragma unroll
                for (int bj = 0; bj < 2; ++bj)
#pragma unroll
                    for (int n = 0; n < 2; ++n) *(LAS f32x4*)(T + ((2 * ai + wr) * 3 + (fr - 13)) * 256 + 128 * bj + lc + 4 * n) = acc[ai][bj][3][n];
        }
        asm volatile("s_waitcnt lgkmcnt(0)" ::: "memory");
        __builtin_amdgcn_s_barrier(); __builtin_amdgcn_s_barrier();
        asm volatile("" ::: "memory");
#pragma unroll
        for (int bj = 0; bj < 2; ++bj)
#pragma unroll
        for (int n = 0; n < 2; ++n) {
            const int gc = pn * 256 + 128 * bj + lc + 4 * n, tc = 128 * bj + lc + 4 * n;
            const f32x4 w0 = *(const f32x4*)(cw + gc), w1 = *(const f32x4*)(cw + D + gc), w2 = *(const f32x4*)(cw + 2 * D + gc), w3 = *(const f32x4*)(cw + 3 * D + gc), bs = *(const f32x4*)(cb + gc);
#pragma unroll
            for (int ai = 0; ai < 2; ++ai) {
                const int slab = 2 * ai + wr;
                f32x4 prev = (f32x4){0.f, 0.f, 0.f, 0.f};
                if (slab > 0 && fr >= 13) prev = *(const LAS f32x4*)(T + ((slab - 1) * 3 + (fr - 13)) * 256 + tc);
#pragma unroll
                for (int m = 0; m < 4; ++m) {
                    const f32x4 xv = acc[ai][bj][m][n];
                    f32x4 y;
#pragma unroll
                    for (int e = 0; e < 4; ++e) {
                        const float X = xv[e], P = prev[e];
                        const float s1 = fr >= 15 ? P : X, s2 = fr >= 14 ? P : X, s3 = fr >= 13 ? P : X;
                        y[e] = bs[e] + w3[e] * X + w2[e] * dpp_ror_f(s1, 1) + w1[e] * dpp_ror_f(s2, 2) + w0[e] * dpp_ror_f(s3, 3);
                    }
                    const int row = pm * 256 + ai * 128 + wr * 64 + m * 16 + fr;
                    *(h4*)(XC + (size_t)row * D + gc) = to_h4(y);
                    if (slab == 0 && m == 0 && fr < 3) *(f32x4*)(XCH + ((size_t)pm * 3 + fr) * D + gc) = y;
                    if (slab == 3 && m == 3 && fr >= 13) {
                        *(f32x4*)(XBT + ((size_t)pm * 3 + (fr - 13)) * D + gc) = xv;
                        if ((pm & 7) == 7) *(f32x4*)(out + O_CP + ((size_t)(pm >> 3) * 3 + (fr - 13)) * D + gc) = xv;
                    }
                    prev = xv;
                }
            }
        }
    }
};

struct GateCols { f32x4 ba, bx, ls; };
struct EmitGates {
    const f16* XC; const float *b_a, *b_x, *lam; unsigned* LB;
    __device__ __forceinline__ GateCols cols(int ch) const {
        GateCols g; g.ba = *(const f32x4*)(b_a + ch) * -1.44269504f; g.bx = *(const f32x4*)(b_x + ch) * -1.44269504f; g.ls = *(const f32x4*)(lam + ch);
        return g; }
    __device__ __forceinline__ unsigned elem(float rp, float ip, float ba, float bx, float ls, float xc) const {
        const float er = __builtin_amdgcn_exp2f(__builtin_fmaf(rp, -1.44269504f, ba)), ei = __builtin_amdgcn_exp2f(__builtin_fmaf(ip, -1.44269504f, bx));
        const float l = ls * __builtin_amdgcn_rcpf(1.f + er);
        const float x2 = 2.f * l;
        const float ser = -x2 * (1.f + x2 * (0.5f + x2 * 0.16666667f));
        const float dir = 1.f - __builtin_amdgcn_exp2f(2.88539008f * l);
        const float om0 = (x2 > -0.03125f) ? ser : dir;
        const int ob = __builtin_bit_cast(int, om0), fl = __builtin_bit_cast(int, 1e-30f);
        const float om = __builtin_bit_cast(float, ob > fl ? ob : fl);
        const float t = 1.f + ei;
        return pack_lb(l, om * __builtin_amdgcn_rsqf(om * t * t) * xc);
    }
    __device__ __forceinline__ void emit2(int row, int ch, const GateCols& g, const f32x4 rp, const f32x4 ip) const {
        const h4 xc = *(const h4*)(XC + (size_t)row * D + ch);
        u32x4 lb;
#pragma unroll
        for (int e = 0; e < 4; ++e) lb[e] = elem(rp[e], ip[e], g.ba[e], g.bx[e], g.ls[e], (float)xc[e]);
        *(u32x4*)(LB + (size_t)row * D + ch) = lb;
    }
    __device__ __forceinline__ void emit8g(int row, int ch, const GateCols& g0, const GateCols& g1, const f32x4 rp0, const f32x4 ip0, const f32x4 rp1, const f32x4 ip1) const {
        const h8 xc = *(const h8*)(XC + (size_t)row * D + ch);
        u32x4 lb0, lb1;
#pragma unroll
        for (int e = 0; e < 4; ++e) { lb0[e] = elem(rp0[e], ip0[e], g0.ba[e], g0.bx[e], g0.ls[e], (float)xc[e]); lb1[e] = elem(rp1[e], ip1[e], g1.ba[e], g1.bx[e], g1.ls[e], (float)xc[4 + e]); }
        unsigned* dst = LB + (size_t)row * D + ch;
        *(u32x4*)dst = lb0; *(u32x4*)(dst + 4) = lb1;
    }
};
struct EpiGates {
    EmitGates em;
    __device__ __forceinline__ void operator()(const f32x4 (&acc)[2][2][4][2], const pg::Unit& u, int wr, int wc, int fr, int fq) const {
        const int chb = (u.pn >> 1) * 256 + (u.pn & 1) * 128 + wc * 32 + 8 * fq;
        const GateCols g0 = em.cols(chb), g1 = em.cols(chb + 4);
#pragma unroll
        for (int ai = 0; ai < 2; ++ai)
#pragma unroll
            for (int m = 0; m < 4; ++m) em.emit8g(u.pm * 256 + ai * 128 + wr * 64 + m * 16 + fr, chb, g0, g1, acc[ai][0][m][0], acc[ai][1][m][0], acc[ai][0][m][1], acc[ai][1][m][1]);
    }
};

template <int NCH, int SPW> __device__ __forceinline__ void thin_unit(const f16* AS, const f16* w0, const f16* w1, int s0, f32x4 (&acc)[NCH][8], int lane) {
    const int fq = lane >> 4;
    const f16* ap = AS + ((size_t)s0 * 8 * 64 + lane) * 8;
    h8 wq[SPW][NCH], aq[SPW][8];
#pragma unroll
    for (int s = 0; s < SPW; ++s) {
        wq[s][0] = *(const h8*)(w0 + s * 32 + 8 * fq); if (NCH == 2) wq[s][NCH - 1] = *(const h8*)(w1 + s * 32 + 8 * fq);
#pragma unroll
        for (int rb = 0; rb < 8; ++rb) aq[s][rb] = *(const h8*)(ap + ((size_t)s * 8 + rb) * 512);
    }
#pragma unroll
    for (int c = 0; c < NCH; ++c)
#pragma unroll
        for (int rb = 0; rb < 8; ++rb) acc[c][rb] = (f32x4){0.f, 0.f, 0.f, 0.f};
#pragma unroll
    for (int s = 0; s < SPW; ++s)
#pragma unroll
        for (int c = 0; c < NCH; ++c)
#pragma unroll
            for (int rb = 0; rb < 8; ++rb) acc[c][rb] = __builtin_amdgcn_mfma_f32_16x16x32_f16(wq[s][c], aq[s][rb], acc[c][rb], 0, 0, 0);
}
template <int NCH> __device__ __forceinline__ void thin_reduce(LAS unsigned char* lds, const f32x4 (&acc)[NCH][8], f32x4 (&tot)[NCH], int wave, int lane) {
    LAS f32x4* red = (LAS f32x4*)lds;
    __syncthreads();
#pragma unroll
    for (int c = 0; c < NCH; ++c)
#pragma unroll
        for (int rb = 0; rb < 8; ++rb) red[(wave * (NCH * 8) + c * 8 + rb) * 64 + lane] = acc[c][rb];
    __syncthreads();
#pragma unroll
    for (int c = 0; c < NCH; ++c) { f32x4 t = red[(c * 8 + wave) * 64 + lane];
#pragma unroll
        for (int w = 1; w < 8; ++w) t += red[(w * (NCH * 8) + c * 8 + wave) * 64 + lane];
        tot[c] = t; }
    __syncthreads();
}

template <class Emit> __device__ __forceinline__ void thin_gemm(LAS unsigned char* lds, const f16* AS, const f16* Bt, int ldb, int ncols, const Emit& em, const int wv_s, const int wg_lo = 0, const int wg_n = 1 << 30) {
    const int tid_ = tid_fresh(), lane = tid_ & 63, wave = tid_ >> 6, fr = lane & 15, fq = lane >> 4;
    const int nwg = wg_n < (int)gridDim.x - wg_lo ? wg_n : (int)gridDim.x - wg_lo;
    if ((int)blockIdx.x < wg_lo || (int)blockIdx.x >= wg_lo + nwg) return;
    for (int u = (int)blockIdx.x - wg_lo; u < ncols / 16; u += nwg) {
        const int n0 = u * 16;
        f32x4 acc[1][8], tot[1];
        thin_unit<1, 4>(AS, Bt + (size_t)(n0 + fr) * ldb + wave * 128, nullptr, wave * 4, acc, lane);
        thin_reduce<1>(lds, acc, tot, wave, lane);
        em.template emit<true>(__builtin_amdgcn_readfirstlane(n0 >> 8), MP + wave * 16 + fr, n0 + 4 * fq, tot[0]);
    }
}
__device__ __forceinline__ void thin_gemm_gates(LAS unsigned char* lds, const f16* AS, const f16* Wg, const EmitGates& em, const int wv_s) {
    const int tid_ = tid_fresh(), lane = tid_ & 63, wave = tid_ >> 6, fr = lane & 15, fq = lane >> 4;
    for (int u = (int)blockIdx.x; u < 64; u += (int)gridDim.x) {
        const int pn = u >> 3, g16 = u & 7;
        const int ch = (pn >> 1) * 256 + (pn & 1) * 128 + g16 * 16 + 4 * fq;
        f32x4 acc[2][8], tot[2];
        thin_unit<2, 1>(AS, Wg + (size_t)(pn * 256 + g16 * 16 + fr) * 256 + wave * 32, Wg + (size_t)(pn * 256 + 128 + g16 * 16 + fr) * 256 + wave * 32, (pn >> 1) * 8 + wave, acc, lane);
        thin_reduce<2>(lds, acc, tot, wave, lane);
        const GateCols g = em.cols(ch);
        em.emit2(MP + wave * 16 + fr, ch, g, tot[0], tot[1]);
    }
}

template <class F, class R> __device__ __forceinline__ void conv_weight(f16* dst, int nrows, int K, F src_at, R dst_row, long gtid_, long gthreads_) {
    const unsigned kc = (unsigned)K / 8u, total = (unsigned)nrows * kc, gtid = (unsigned)gtid_, gthreads = (unsigned)gthreads_;
    for (unsigned ch = gtid; ch < total; ch += 2u * gthreads) {
        const unsigned ch2 = ch + gthreads; const bool two = ch2 < total;
        const int k0 = (int)(ch / (unsigned)nrows) * 8, n = (int)(ch - (unsigned)(k0 / 8) * (unsigned)nrows);
        const int k02 = two ? (int)(ch2 / (unsigned)nrows) * 8 : k0, n2 = two ? (int)(ch2 - (unsigned)(k02 / 8) * (unsigned)nrows) : n;
        float a[8], c[8];
#pragma unroll
        for (int j = 0; j < 8; ++j) { a[j] = src_at(k0 + j, n); c[j] = src_at(k02 + j, n2); }
        h8 v, v2;
#pragma unroll
        for (int j = 0; j < 8; ++j) { v[j] = (f16)a[j]; v2[j] = (f16)c[j]; }
        *(h8*)(dst + (size_t)dst_row(n) * K + k0) = v;
        if (two) *(h8*)(dst + (size_t)dst_row(n2) * K + k02) = v2;
    }
}

constexpr int CT_WIN = NIN * 16, CT_WO0 = CT_WIN + D * 16, CT_WLIN = CT_WO0 + 2 * D * 16, CT_WLO = CT_WLIN + D * 16, CT_WA = CT_WLO + 1024 * 4, CT_WX = CT_WA + 1024 * 4, CT_TRIPS = CT_WX / 512;
static_assert(CT_WIN % 512 == 0 && CT_WX % 512 == 0, "trip granularity");
__device__ __forceinline__ void conv_trip(CParams& p, const int trip, const int tid) {
    const int it0 = __builtin_amdgcn_readfirstlane(trip * 512);
    const unsigned it = (unsigned)(it0 + tid);
    const float* base; unsigned off0, stride; f16* dst; bool valid = true;
    if (it0 < CT_WIN) {
        const unsigned kc = it / (unsigned)NIN; const int n = (int)(it - kc * (unsigned)NIN);
        int c; if (n < 2560) c = n; else if (n < 3584) c = n - 2560 + 2640; else if (n < 3648) c = n - 3584 + 2560; else if (n < 3664) c = n - 3648 + 2624; else c = -1;
        valid = c >= 0; base = p.w_in; off0 = kc * 64u * 3664u + (unsigned)(valid ? c : 0); stride = 3664u; dst = (f16*)(p.ws + WS_WIN) + (size_t)n * D + kc * 64;
    } else if (it0 < CT_WO0) { const unsigned l = it - CT_WIN, kc = l >> 10, n = l & 1023u;
        base = p.w_out0; off0 = kc * 64u * D + n; stride = D; dst = (f16*)(p.ws + WS_WO0) + (size_t)n * D + kc * 64;
    } else if (it0 < CT_WLIN) { const unsigned l = it - CT_WO0, kc = l >> 11, n = l & 2047u;
        base = p.lw_in; off0 = kc * 64u * 2u * D + n; stride = 2 * D; dst = (f16*)(p.ws + WS_WLIN) + (size_t)n * D + kc * 64;
    } else if (it0 < CT_WLO) { const unsigned l = it - CT_WLIN, kc = l >> 10, n = l & 1023u;
        base = p.lw_out; off0 = kc * 64u * D + n; stride = D; dst = (f16*)(p.ws + WS_WLO) + (size_t)n * D + kc * 64;
    } else {
        const bool isx = it0 >= CT_WA; const unsigned l = it - (isx ? CT_WA : CT_WLO), kc = l >> 10, n = l & 1023u;
        base = isx ? p.w_x : p.w_a;
        off0 = ((n >> 8) * 256u + kc * 64u) * 256u + (n & 255u); stride = 256u; dst = (f16*)(p.ws + WS_WG) + (size_t)((n >> 7) * 256u + (isx ? 128u : 0u) + (n & 127u)) * 256 + kc * 64;
    }
    float a[64];
#pragma unroll
    for (int j = 0; j < 64; ++j) a[j] = base[off0 + (unsigned)j * stride];
#pragma unroll
    for (int q = 0; q < 8; ++q) { h8 v;
#pragma unroll
        for (int e = 0; e < 8; ++e) v[e] = valid ? (f16)a[q * 8 + e] : (f16)0.f;
        *(h8*)(dst + q * 8) = v; }
}

__device__ __forceinline__ void ph0_prologue(CParams& p, LAS unsigned char* lds, const int wv_s) {
    const int tid = tid_fresh();
    const long gtid = (long)blockIdx.x * NTHR + tid, gth = (long)gridDim.x * NTHR;
    float* ADA = (float*)(p.ws + WS_ADA);
    LAS float* sc = (LAS float*)lds;
    LAS float* red = (LAS float*)(lds + 98304);
    const int cl = tid & 31, ks = tid >> 5;
    for (int item = blockIdx.x; item < 192; item += gridDim.x) {
        const int l = item / 96, cg = item % 96, col = cg * 32 + cl;
        const float* aw = p.ada_w + (size_t)l * D * 3072 + (size_t)ks * 64 * 3072 + col;
        float w[64];
#pragma unroll
        for (int i = 0; i < 64; ++i) w[i] = aw[(size_t)i * 3072];
        for (int half = 0; half < 2; ++half) {
            __syncthreads();
            for (int e = tid; e < 24 * 1024; e += NTHR) { const int r = 24 * half + (e >> 10), k = e & 1023; const float c = r < 16 ? p.c_p[r * D + k] : p.c_s[(r - 16) * D + k]; sc[e] = c * __builtin_amdgcn_rcpf(1.f + __expf(-c)); }
            __syncthreads();
            f32x2 acc[24];
            const LAS float *sc_lo = sc + ks * 64, *sc_hi = sc + 12 * 1024 + ks * 64; asm volatile("" : "+v"(sc_lo), "+v"(sc_hi));
#pragma unroll
            for (int r = 0; r < 24; ++r) acc[r] = (f32x2){0.f, 0.f};
#pragma unroll
            for (int k4 = 0; k4 < 16; ++k4) {
                const f32x2 wa = {w[4 * k4], w[4 * k4 + 1]}, wb = {w[4 * k4 + 2], w[4 * k4 + 3]};
#pragma unroll
                for (int rh = 0; rh < 2; ++rh) {
#pragma unroll
                    for (int r = 12 * rh; r < 12 * rh + 12; ++r) { const f32x4 s4 = *(const LAS f32x4*)((r < 12 ? sc_lo : sc_hi) + (r % 12) * 1024 + 4 * k4);
                        acc[r] = __builtin_elementwise_fma((f32x2){s4[0], s4[1]}, wa, acc[r]); acc[r] = __builtin_elementwise_fma((f32x2){s4[2], s4[3]}, wb, acc[r]); }
                    __builtin_amdgcn_sched_barrier(0);
                }
            }
#pragma unroll
            for (int r = 0; r < 24; ++r) red[(ks * 24 + r) * 32 + cl] = acc[r][0] + acc[r][1];
            __syncthreads();
            for (int e = tid; e < 768; e += NTHR) { const int r = e >> 5, c2 = e & 31; float s = 0.f;
                for (int q = 0; q < 16; ++q) s += red[(q * 24 + r) * 32 + c2];
                const int cc = cg * 32 + c2; ADA[((size_t)l * 48 + 24 * half + r) * 3072 + cc] = s + p.ada_b[l * 3072 + cc]; }
        }
    }
    __syncthreads();
    { float* LS = (float*)(p.ws + WS_LS); for (long i = gtid; i < D; i += gth) LS[i] = -8.f * log1pf(expf(-p.lam[i])); }
    { float* ROPE = (float*)(p.ws + WS_ROPE);
      for (long i = gtid; i < (long)(SEQ + DT) * 24; i += gth) { const int idx = (int)(i / 24), f = (int)(i % 24); const int pos = idx < SEQ ? idx : PAST + (idx - SEQ);
          float c, sn; rope_cs(pos, f < 16 ? INV32[f] : INV16[f - 16], c, sn); ROPE[i * 2] = c; ROPE[i * 2 + 1] = sn; } }
    {
        const int G = (int)gridDim.x, nada = G < 192 ? G : 192;
        const int w2 = ((int)blockIdx.x + G - nada) % G;
        for (int t = w2; t < CT_TRIPS; t += G) conv_trip(p, t, tid);
    }
}

__device__ __forceinline__ void ph_modulate(const float* xa, const float* xb, const float* ng, const float* ada, f16* H, f16* HS, const int wv_s) {
    const int tid_ = tid_fresh(), lane = tid_ & 63, gw = blockIdx.x * 8 + (tid_ >> 6), nw = gridDim.x * 8;
    for (int row = gw; row < MPAD; row += nw) {
        f16* hr = H + (size_t)row * D;
        if (row >= MT) {
#pragma unroll
            for (int i = 0; i < 4; ++i) *(h4*)(hr + (i * 64 + lane) * 4) = (h4){(f16)0.f, (f16)0.f, (f16)0.f, (f16)0.f};
            continue; }
        const float* src = row < MP ? xa + (size_t)row * D : xb + (size_t)(row - MP) * D;
        const float* ar = ada + (size_t)row_arow(row) * 3072;
        f32x4 xv[4]; float ss = 0.f;
#pragma unroll
        for (int i = 0; i < 4; ++i) { xv[i] = *(const f32x4*)(src + (i * 64 + lane) * 4); ss += xv[i][0] * xv[i][0] + xv[i][1] * xv[i][1] + xv[i][2] * xv[i][2] + xv[i][3] * xv[i][3]; }
        ss = wave_sum(ss);
        const float rs = rsqrtf(ss * (1.f / D) + EPS);
#pragma unroll
        for (int i = 0; i < 4; ++i) { const int c = (i * 64 + lane) * 4;
            const f32x4 g = *(const f32x4*)(ng + c), sh = *(const f32x4*)(ar + c), scv = *(const f32x4*)(ar + 1024 + c);
            f32x4 y;
#pragma unroll
            for (int e = 0; e < 4; ++e) y[e] = (xv[i][e] * rs * g[e]) * (1.f + scv[e]) + sh[e];
            if (row < MP) *(h4*)(hr + c) = to_h4(y); else *(h4*)(HS + as16_off(row - MP, c)) = to_h4(y); }
    }
}

__device__ __forceinline__ void ph3_fixup(CParams& p, const int wv_s) {
    const int tid_ = tid_fresh(), lane = tid_ & 63, gw = blockIdx.x * 8 + (tid_ >> 6), nw = gridDim.x * 8;
    f16* Q = (f16*)(p.ws + WS_Q); f16* QI = (f16*)(p.ws + WS_QI); f16* KH = (f16*)(p.ws + WS_KH); f16* KIH = (f16*)(p.ws + WS_KIH);
    for (int row = gw; row < MT; row += nw) {
        const int pos = row_pos(row); const bool smp = row >= MP; const int rs_ = row - MP;
        float cs = 1.f, sn = 0.f;
        { const double inv = lane < 16 ? INV32[lane] : (lane < 24 ? INV16[lane - 16] : 0.0);
          double rev = (double)pos * inv * 0.15915494309189535; rev -= floor(rev); const float rf = (float)rev;
          cs = __builtin_amdgcn_cosf(rf); sn = __builtin_amdgcn_sinf(rf); }
        {
            float* kp = (smp ? p.out + O_KS + (size_t)rs_ * 256 : p.out + O_K + (size_t)row * 256) + lane * 4;
            f32x4 v = *(const f32x4*)kp;
            float ss = v[0] * v[0] + v[1] * v[1] + v[2] * v[2] + v[3] * v[3];
            ss += __shfl_xor(ss, 1); ss += __shfl_xor(ss, 2); ss += __shfl_xor(ss, 4); ss += __shfl_xor(ss, 8); ss += __shfl_xor(ss, 16);
            const float rn = rsqrtf(ss * (1.f / 128.f) + EPS);
            const int l5 = lane & 31;
            const f32x4 kn = *(const f32x4*)(p.k_norm + l5 * 4);
#pragma unroll
            for (int e = 0; e < 4; ++e) v[e] = v[e] * rn * kn[e];
#pragma unroll
            for (int e = 0; e < 4; ++e) {
                const float o = __shfl_xor(v[e], 4); const int fi = ((l5 & 3) * 4 + e) & 15; const float c = __shfl(cs, fi), s = __shfl(sn, fi);
                if (l5 < 4) v[e] = v[e] * c - o * s; else if (l5 < 8) v[e] = v[e] * c + o * s;
            }
            *(f32x4*)kp = v;
            if (l5 >= 8) { const f32x4 qn4 = *(const f32x4*)(p.q_norm + l5 * 4); v = v * qn4; }
            *(h4*)(KH + (size_t)row * 256 + lane * 4) = to_h4(v);
        }
        {
            float* kp = (smp ? p.out + O_IKS + (size_t)rs_ * 64 : p.out + O_IK + (size_t)row * 64) + lane;
            float v = *kp; const float o = __shfl_xor(v, 8); const float c = __shfl(cs, 16 + (lane & 7)), s = __shfl(sn, 16 + (lane & 7));
            if (lane < 8) v = v * c - o * s; else if (lane < 16) v = v * c + o * s;
            *kp = v;
            if (smp) KIH[(size_t)row * 64 + lane] = (f16)v;
            else { const int b_ = row >> 11, ps = row & (SEQ - 1);
                KIH[((((size_t)(b_ * 64 + (ps >> 5)) * 4 + (lane >> 4)) * 2 + ((lane >> 3) & 1)) * 32 + (ps & 31)) * 8 + (lane & 7)] = (f16)v; }
        }
    }
}

#define DPP_ROW_SHR(n) (0x110 + (n))
#define DPP_ROW_BCAST15 0x142
#define DPP_ROW_BCAST31 0x143
#define dpp_f(old, src, ctrl, row_mask, bc) __int_as_float(__builtin_amdgcn_update_dpp(__float_as_int(old), __float_as_int(src), (ctrl), (row_mask), 0xf, (bc)))
__device__ __forceinline__ float wave_max_dpp(float v) {
    v = fmaxf(v, dpp_f(v, v, DPP_ROW_SHR(1), 0xf, false)); v = fmaxf(v, dpp_f(v, v, DPP_ROW_SHR(2), 0xf, false));
    v = fmaxf(v, dpp_f(v, v, DPP_ROW_SHR(4), 0xf, false)); v = fmaxf(v, dpp_f(v, v, DPP_ROW_SHR(8), 0xf, false));
    v = fmaxf(v, dpp_f(v, v, DPP_ROW_BCAST15, 0xa, false)); v = fmaxf(v, dpp_f(v, v, DPP_ROW_BCAST31, 0xc, false));
    return __int_as_float(__builtin_amdgcn_readlane(__float_as_int(v), 63)); }
__device__ __forceinline__ float wave_min_dpp(float v) {
    v = fminf(v, dpp_f(v, v, DPP_ROW_SHR(1), 0xf, false)); v = fminf(v, dpp_f(v, v, DPP_ROW_SHR(2), 0xf, false));
    v = fminf(v, dpp_f(v, v, DPP_ROW_SHR(4), 0xf, false)); v = fminf(v, dpp_f(v, v, DPP_ROW_SHR(8), 0xf, false));
    v = fminf(v, dpp_f(v, v, DPP_ROW_BCAST15, 0xa, false)); v = fminf(v, dpp_f(v, v, DPP_ROW_BCAST31, 0xc, false));
    return __int_as_float(__builtin_amdgcn_readlane(__float_as_int(v), 63)); }
__device__ __forceinline__ unsigned wave_prefix_dpp(unsigned x, unsigned& tot, int lane) {
    int v = (int)x;
    v += __builtin_amdgcn_update_dpp(0, v, DPP_ROW_SHR(1), 0xf, 0xf, true);
    v += __builtin_amdgcn_update_dpp(0, v, DPP_ROW_SHR(2), 0xf, 0xf, true);
    v += __builtin_amdgcn_update_dpp(0, v, DPP_ROW_SHR(4), 0xf, 0xf, true);
    v += __builtin_amdgcn_update_dpp(0, v, DPP_ROW_SHR(8), 0xf, 0xf, true);
    const int t0 = __builtin_amdgcn_readlane(v, 15), t1 = __builtin_amdgcn_readlane(v, 31), t2 = __builtin_amdgcn_readlane(v, 47), t3 = __builtin_amdgcn_readlane(v, 63);
    const int rowi = lane >> 4;
    const int add = rowi == 0 ? 0 : (rowi == 1 ? t0 : (rowi == 2 ? t0 + t1 : t0 + t1 + t2));
    tot = (unsigned)(t0 + t1 + t2 + t3);
    return (unsigned)(v + add);
}

__device__ __forceinline__ unsigned ord16(float sc) { const unsigned h = (unsigned)__builtin_bit_cast(unsigned short, (f16)sc); const int m = __builtin_amdgcn_sbfe((int)h, 15, 1); return (h ^ ((unsigned)m | 0x8000u)) & 0xFFFFu; }
__device__ __forceinline__ void radix_find(const LAS unsigned* hist, int k, int lane, int& B, int& r) {
    const u32x4 hc = *(const LAS u32x4*)(hist + lane * 4);
    const unsigned s4 = hc.x + hc.y + hc.z + hc.w;
    unsigned tot; const unsigned pre = wave_prefix_dpp(s4, tot, lane);
    const unsigned above = tot - pre;
    const bool mine = (above < (unsigned)k) && (above + s4 >= (unsigned)k);
    int B1 = 0, r1 = 1;
    { unsigned c = above; const unsigned hb[4] = {hc.x, hc.y, hc.z, hc.w}; bool found = false;
#pragma unroll
      for (int b = 3; b >= 0; --b) { if (!found && c + hb[b] >= (unsigned)k) { B1 = lane * 4 + b; r1 = k - (int)c; found = true; } c += hb[b]; } }
    const u64 bmn = __ballot(mine);
    const int srcl = bmn ? (int)__builtin_ctzll(bmn) : 0;
    B = __builtin_amdgcn_readlane(B1, srcl); r = __builtin_amdgcn_readlane(r1, srcl);
}
__device__ __forceinline__ int wave_max_i_dpp(int v) {
    v = max(v, __builtin_amdgcn_update_dpp(v, v, DPP_ROW_SHR(1), 0xf, 0xf, false)); v = max(v, __builtin_amdgcn_update_dpp(v, v, DPP_ROW_SHR(2), 0xf, 0xf, false));
    v = max(v, __builtin_amdgcn_update_dpp(v, v, DPP_ROW_SHR(4), 0xf, 0xf, false)); v = max(v, __builtin_amdgcn_update_dpp(v, v, DPP_ROW_SHR(8), 0xf, 0xf, false));
    v = max(v, __builtin_amdgcn_update_dpp(v, v, DPP_ROW_BCAST15, 0xa, 0xf, false)); v = max(v, __builtin_amdgcn_update_dpp(v, v, DPP_ROW_BCAST31, 0xc, 0xf, false));
    return __builtin_amdgcn_readlane(v, 63); }
__device__ __forceinline__ int wave_min_i_dpp(int v) {
    v = min(v, __builtin_amdgcn_update_dpp(v, v, DPP_ROW_SHR(1), 0xf, 0xf, false)); v = min(v, __builtin_amdgcn_update_dpp(v, v, DPP_ROW_SHR(2), 0xf, 0xf, false));
    v = min(v, __builtin_amdgcn_update_dpp(v, v, DPP_ROW_SHR(4), 0xf, 0xf, false)); v = min(v, __builtin_amdgcn_update_dpp(v, v, DPP_ROW_SHR(8), 0xf, 0xf, false));
    v = min(v, __builtin_amdgcn_update_dpp(v, v, DPP_ROW_BCAST15, 0xa, 0xf, false)); v = min(v, __builtin_amdgcn_update_dpp(v, v, DPP_ROW_BCAST31, 0xc, 0xf, false));
    return __builtin_amdgcn_readlane(v, 63); }
__device__ __forceinline__ u64 wave_select_mask(const LAS unsigned short* S, int n, int k, LAS unsigned* hist, LAS u64* mb, int lane) {
    if (n <= k) { const int m_ = n - 64 * lane; return m_ >= 64 ? ~0ull : (m_ <= 0 ? 0ull : ((1ull << m_) - 1ull)); }
    int d[32]; int kmin = 0xFFFF, kmax = 0;
#pragma unroll
    for (int j = 0; j < 32; ++j) { const int idx = j * 64 + lane; const int key = (idx < n) ? (int)S[idx] : -1; d[j] = key; kmax = max(kmax, key); kmin = min(kmin, key < 0 ? 0xFFFF : key); }
    kmin = wave_min_i_dpp(kmin); kmax = wave_max_i_dpp(kmax);
    const int span = kmax - kmin;
    const int sh = span < 256 ? 0 : (24 - __builtin_clz((unsigned)span));
    const int dump = 256 + lane;
    *(LAS u32x4*)(hist + lane * 4) = (u32x4){0u, 0u, 0u, 0u};
    WSYNC();
#pragma unroll
    for (int j = 0; j < 32; ++j) { const bool ok = d[j] >= 0; d[j] = d[j] - kmin;
        __hip_atomic_fetch_add(&hist[ok ? (d[j] >> sh) : dump], 1u, __ATOMIC_RELAXED, __HIP_MEMORY_SCOPE_WORKGROUP); }
    WSYNC();
    int B1, r1; radix_find(hist, k, lane, B1, r1);
    WSYNC();
    *(LAS u32x4*)(hist + lane * 4) = (u32x4){0u, 0u, 0u, 0u};
    WSYNC();
    const int lowmask = (1 << sh) - 1;
#pragma unroll
    for (int j = 0; j < 32; ++j) { const bool in1 = (d[j] >= 0) && ((d[j] >> sh) == B1);
        __hip_atomic_fetch_add(&hist[in1 ? (d[j] & lowmask) : dump], 1u, __ATOMIC_RELAXED, __HIP_MEMORY_SCOPE_WORKGROUP); }
    WSYNC();
    int B2, r2; radix_find(hist, r1, lane, B2, r2);
    const int thr = (B1 << sh) + B2;
    WSYNC();
#pragma unroll
    for (int j = 0; j < 32; ++j) { const u64 bm = __ballot(d[j] >= thr); if (lane == 0) mb[j] = bm; }
    WSYNC();
    const u64 res = mb[lane & 31];
    WSYNC();
    return res;
}

__device__ __forceinline__ void qi_rope(h8& a0, const float* ROPE, int pos, int hh) {
    const float* rr = rope_row(ROPE, pos, 16);
    const f32x4 t0 = *(const f32x4*)rr, t1 = *(const f32x4*)(rr + 4), t2 = *(const f32x4*)(rr + 8), t3 = *(const f32x4*)(rr + 12);
    const float cs[16] = {t0[0], t0[1], t0[2], t0[3], t1[0], t1[1], t1[2], t1[3], t2[0], t2[1], t2[2], t2[3], t3[0], t3[1], t3[2], t3[3]};
#pragma unroll
    for (int jj = 0; jj < 8; ++jj) { const float c = cs[2 * jj], sn = cs[2 * jj + 1]; const float mine = (float)a0[jj], other = __shfl_xor(mine, 32);
        a0[jj] = (f16)(hh ? (mine * c + other * sn) : (mine * c - other * sn)); }
}
#define PHA_COMMON \
    const int tid = tid_fresh(), lane = tid & 63, wave = tid >> 6, r = lane & 31, hh = lane >> 5; \
    const f16* QI = (const f16*)(p.ws + WS_QI); const f16* KIH = (const f16*)(p.ws + WS_KIH); const float* WI = (const float*)(p.ws + WS_WI); \
    unsigned* MASK = (unsigned*)(p.ws + WS_MASK); float* SCS = (float*)(p.ws + WS_SCS); \
    const int qsel = (r >> 2) & 1, ahead = (r & 3) + 4 * (r >> 3); (void)tid; (void)MASK; (void)SCS; (void)KIH; (void)qsel; (void)ahead; (void)WI; (void)QI;
__device__ __forceinline__ void phA_sample(CParams& p, LAS unsigned char* lds, const int wv_s) {
    PHA_COMMON
    for (int it = blockIdx.x * 8 + wave; it < DB * NPG; it += gridDim.x * 8) {
        const int b = it / NPG, pg_ = it % NPG; const int phys = p.page_table[b * NPG + pg_];
        const float* kp0 = p.cache_ik + ((size_t)phys * PAGE + r) * 64 + 8 * hh;
        f32x4 raw[2][8];
#pragma unroll
        for (int s = 0; s < 4; ++s) { raw[0][2 * s] = *(const f32x4*)(kp0 + 16 * s); raw[0][2 * s + 1] = *(const f32x4*)(kp0 + 16 * s + 4); }
        h8 af[2][4]; float wv[2][16];
#pragma unroll
        for (int mt = 0; mt < 2; ++mt) {
            const int rowa = MP + b * 4 + 2 * mt + qsel, roww = MP + b * 4 + 2 * mt + hh;
#pragma unroll
            for (int s = 0; s < 4; ++s) af[mt][s] = *(const h8*)(QI + (size_t)rowa * D + ahead * 64 + 16 * s + 8 * hh);
            qi_rope(af[mt][0], (const float*)(p.ws + WS_ROPE), PAST + 2 * mt + qsel, hh);
#pragma unroll
            for (int q4 = 0; q4 < 4; ++q4) { const f32x4 w4 = *(const f32x4*)(WI + (size_t)roww * 16 + q4 * 4); wv[mt][q4 * 4] = w4[0]; wv[mt][q4 * 4 + 1] = w4[1]; wv[mt][q4 * 4 + 2] = w4[2]; wv[mt][q4 * 4 + 3] = w4[3]; }
        }
#pragma unroll
        for (int kt = 0; kt < 4; ++kt) {
            if (kt < 3) { const float* kp = kp0 + (size_t)(kt + 1) * 32 * 64;
#pragma unroll
                for (int s = 0; s < 4; ++s) { raw[(kt + 1) & 1][2 * s] = *(const f32x4*)(kp + 16 * s); raw[(kt + 1) & 1][2 * s + 1] = *(const f32x4*)(kp + 16 * s + 4); } }
            h8 bf[4];
#pragma unroll
            for (int s = 0; s < 4; ++s) { const f32x4 a = raw[kt & 1][2 * s], c = raw[kt & 1][2 * s + 1];
                bf[s][0] = (f16)a[0]; bf[s][1] = (f16)a[1]; bf[s][2] = (f16)a[2]; bf[s][3] = (f16)a[3]; bf[s][4] = (f16)c[0]; bf[s][5] = (f16)c[1]; bf[s][6] = (f16)c[2]; bf[s][7] = (f16)c[3]; }
#pragma unroll
            for (int mt = 0; mt < 2; ++mt) {
                f32x16 acc;
#pragma unroll
                for (int e = 0; e < 16; ++e) acc[e] = 0.f;
#pragma unroll
                for (int s = 0; s < 4; ++s) acc = __builtin_amdgcn_mfma_f32_32x32x16_f16(af[mt][s], bf[s], acc, 0, 0, 0);
                float sc = 0.f;
#pragma unroll
                for (int e = 0; e < 16; ++e) sc += wv[mt][e] * relu_f(acc[e]);
                SCS[(size_t)(b * 4 + 2 * mt + hh) * LSP + pg_ * PAGE + kt * 32 + r] = sc;
            }
        }
    }
    for (int b = blockIdx.x * 8 + wave; b < DB; b += gridDim.x * 8) {
        const int t = lane >> 4, h = lane & 15; const int rowq = MP + b * 4 + t;
        const float w = WI[(size_t)rowq * 16 + h];
        float dots[4] = {0.f, 0.f, 0.f, 0.f};
        h8 qr0 = *(const h8*)(QI + (size_t)rowq * D + h * 64), qr1 = *(const h8*)(QI + (size_t)rowq * D + h * 64 + 8);
#pragma unroll
        for (int jj = 0; jj < 8; ++jj) { const float* rr = rope_row((const float*)(p.ws + WS_ROPE), PAST + t, 16 + jj); const float c = rr[0], sn = rr[1]; const float x1 = (float)qr0[jj], x2 = (float)qr1[jj]; qr0[jj] = (f16)(x1 * c - x2 * sn); qr1[jj] = (f16)(x2 * c + x1 * sn); }
        for (int d0 = 0; d0 < 64; d0 += 8) {
            const h8 qv = d0 == 0 ? qr0 : (d0 == 8 ? qr1 : *(const h8*)(QI + (size_t)rowq * D + h * 64 + d0));
#pragma unroll
            for (int t2 = 0; t2 < 4; ++t2) { const h8 kv = *(const h8*)(KIH + (size_t)(MP + b * 4 + t2) * 64 + d0);
#pragma unroll
                for (int j = 0; j < 8; ++j) dots[t2] += (float)qv[j] * (float)kv[j]; }
        }
#pragma unroll
        for (int t2 = 0; t2 < 4; ++t2) { float s = w * fmaxf(dots[t2], 0.f);
            s += __shfl_xor(s, 1); s += __shfl_xor(s, 2); s += __shfl_xor(s, 4); s += __shfl_xor(s, 8);
            if (h == 0) SCS[(size_t)(b * 4 + t) * LSP + PAST + t2] = (t2 <= t) ? s : -3.0e38f; }
    }
}
template <bool SELECT> __device__ __forceinline__ void phA_prompt(CParams& p, LAS unsigned char* lds, const int wv_s) {
    PHA_COMMON
    LAS unsigned short* S = (LAS unsigned short*)lds + wave * 8192;
    LAS unsigned* hist = (LAS unsigned*)(lds + LDS_AUX + wave * 1536);
    LAS u64* mb = (LAS u64*)(lds + LDS_AUX + wave * 1536 + 1280);
    const float* ROPE = (const float*)(p.ws + WS_ROPE);
    if (blockIdx.x < 256)
    for (int j = 0; j < 4; ++j) {
        const int wq = blockIdx.x >> 4, b = blockIdx.x & 15;
        const int qt = (j == 0) ? wq : (j == 1 ? 31 - wq : (j == 2 ? 32 + wq : 63 - wq));
        const int q0 = qt * 32 + 4 * wv_s;
        const size_t tok0 = (size_t)b * SEQ;
        h8 af[2][4]; float wv[2][16];
#pragma unroll
        for (int mt = 0; mt < 2; ++mt) {
#pragma unroll
            for (int s = 0; s < 4; ++s) af[mt][s] = *(const h8*)(QI + (tok0 + q0 + 2 * mt + qsel) * D + ahead * 64 + 16 * s + 8 * hh);
            qi_rope(af[mt][0], ROPE, q0 + 2 * mt + qsel, hh);
#pragma unroll
            for (int q4 = 0; q4 < 4; ++q4) { const f32x4 w4 = *(const f32x4*)(WI + (tok0 + q0 + 2 * mt + hh) * 16 + q4 * 4); wv[mt][q4 * 4] = w4[0]; wv[mt][q4 * 4 + 1] = w4[1]; wv[mt][q4 * 4 + 2] = w4[2]; wv[mt][q4 * 4 + 3] = w4[3]; }
        }
        const int nkt = (q0 + 3) / 32 + 1;
        const f16* kbase = KIH + (size_t)b * 64 * 2048; const unsigned loff = (unsigned)lane * 8u;
        h8 bq[4][4];
#pragma unroll
        for (int u = 0; u < 4; ++u) { const int kk = u < nkt ? u : nkt - 1; const f16* kp = kbase + (size_t)kk * 2048;
#pragma unroll
            for (int s = 0; s < 4; ++s) bq[u][s] = *(const h8*)(kp + loff + 512 * s); }
#define IX_CHAIN(ACC, MT, BQ) { _Pragma("unroll") for (int e = 0; e < 16; ++e) ACC[e] = 0.f; \
        _Pragma("unroll") for (int s = 0; s < 4; ++s) ACC = __builtin_amdgcn_mfma_f32_32x32x16_f16(af[MT][s], BQ[s], ACC, 0, 0, 0); }
#define IX_SUM(ACC, MT, KT) { float sa = 0.f, sb = 0.f; _Pragma("unroll") for (int e = 0; e < 16; e += 2) { sa += wv[MT][e] * relu_f(ACC[e]); sb += wv[MT][e + 1] * relu_f(ACC[e + 1]); } \
        S[(2 * (MT) + hh) * 2048 + (KT) * 32 + r] = (unsigned short)ord16(sa + sb); }
#define IX_MIX() { _Pragma("unroll") for (int i = 0; i < 4; ++i) { __builtin_amdgcn_sched_group_barrier(0x008, 1, 0); __builtin_amdgcn_sched_group_barrier(0x002, 8, 0); } }
        f32x16 accA, accB;
        IX_CHAIN(accA, 0, bq[0])
        for (int kt0 = 0; kt0 < nkt; kt0 += 4) {
#pragma unroll
            for (int u = 0; u < 4; ++u) {
                const int kt = kt0 + u, un = (u + 1) & 3;
                IX_CHAIN(accB, 1, bq[u])
                IX_SUM(accA, 0, kt)
                IX_MIX()
                { const int kn = kt + 4; const int kk = kn < nkt ? kn : nkt - 1; const f16* kp = kbase + (size_t)kk * 2048;
#pragma unroll
                  for (int s = 0; s < 4; ++s) bq[u][s] = *(const h8*)(kp + loff + 512 * s); }
                IX_CHAIN(accA, 0, bq[un])
                IX_SUM(accB, 1, kt)
                IX_MIX()
            }
        }
#undef IX_CHAIN
#undef IX_SUM
#undef IX_MIX
        WSYNC();
        if (SELECT)
        for (int qq = 0; qq < 4; ++qq) {
            const int pos = q0 + qq; const int n = pos + 1;
            const u64 mine = wave_select_mask(S + qq * 2048, n, 256, hist, mb, lane);
            if (lane < 32) *(u64*)(MASK + (tok0 + pos) * 64 + lane * 2) = mine;
        }
        WSYNC();
    }
}

__device__ __forceinline__ void phB_sample(CParams& p, LAS unsigned char* lds, const int wv_s) {
    const int tid = tid_fresh(), lane = tid & 63, wave = tid >> 6;
    if (blockIdx.x >= MS) return;
    const int row = blockIdx.x;
    const int b = row >> 2, t = row & 3; const int n = PAST + t + 1;
    LAS unsigned* hist = (LAS unsigned*)(lds + LDS_AUX);
    LAS float* cand = (LAS float*)(lds + LDS_AUX + 4096);
    LAS float* red = (LAS float*)(lds + LDS_AUX + 4352);
    LAS int* idxl = (LAS int*)(lds + LDS_AUX + 4864);
    LAS int* rowl = (LAS int*)(lds + LDS_AUX + 5888);
    LAS float* qs = (LAS float*)(lds + LDS_AUX + 6912);
    LAS float* s2 = (LAS float*)(lds + LDS_AUX + 11008);
    LAS unsigned* cnt = (LAS unsigned*)(red + 16);
    const float* SCS = (const float*)(p.ws + WS_SCS) + (size_t)row * LSP;
    const f16* Q = (const f16*)(p.ws + WS_Q) + (size_t)(MP + row) * D;
    constexpr int NV = 33;
    float v[NV];
#pragma unroll
    for (int j = 0; j < NV; ++j) { const int i = j * NTHR + tid; v[j] = (i < n) ? SCS[i] : -3.0e38f; }
    __syncthreads();
    qs[tid] = (float)Q[tid]; qs[tid + NTHR] = (float)Q[tid + NTHR];
    if (tid < 256) { idxl[tid] = -1; rowl[tid] = 0; }
    __syncthreads();
    {
        const float a = qs[wave * 128 + lane], b2 = qs[wave * 128 + 64 + lane];
        const float rn = rsqrtf(wave_sum(a * a + b2 * b2) * (1.f / 128.f) + EPS) * 0.12751743f;
        float ya = a * rn * p.q_norm[lane], yb = b2 * rn * p.q_norm[64 + lane];
        const float oth = __shfl_xor(ya, 16);
        if (lane < 32) { const float* rr = rope_row((const float*)(p.ws + WS_ROPE), PAST + t, lane & 15); const float c = rr[0], sn = rr[1]; ya = lane < 16 ? (ya * c - oth * sn) : (ya * c + oth * sn); }
        qs[wave * 128 + lane] = ya; qs[wave * 128 + 64 + lane] = yb;
    }
    float lo = 3.0e38f, hi = -3.0e38f;
#pragma unroll
    for (int j = 0; j < NV; ++j) { hi = fmaxf(hi, v[j]); lo = fminf(lo, (j * NTHR + tid < n) ? v[j] : 3.0e38f); }
    lo = wave_min_dpp(lo); hi = wave_max_dpp(hi);
    if (lane == 0) { red[wave] = lo; red[8 + wave] = hi; }
    __syncthreads();
    lo = red[0]; hi = red[8];
#pragma unroll
    for (int w = 1; w < 8; ++w) { lo = fminf(lo, red[w]); hi = fmaxf(hi, red[8 + w]); }
    float thr = lo; int k = 256;
    for (int iter = 0; iter < 12; ++iter) {
        if (!(hi > lo)) { thr = lo; break; }
        const float scale = 1024.0f / (hi - lo);
        __syncthreads();
        if (tid < 256) *(LAS u32x4*)(hist + tid * 4) = (u32x4){0u, 0u, 0u, 0u};
        if (tid == 0) *cnt = 0u;
        __syncthreads();
#pragma unroll
        for (int j = 0; j < NV; ++j) { const float x = v[j];
            if (x >= lo && x <= hi) { int bb = (int)((x - lo) * scale); bb = bb > 1023 ? 1023 : bb; __hip_atomic_fetch_add(&hist[bb], 1u, __ATOMIC_RELAXED, __HIP_MEMORY_SCOPE_WORKGROUP); } }
        __syncthreads();
        u32x4 hc[4]; unsigned s16 = 0u;
#pragma unroll
        for (int q = 0; q < 4; ++q) { hc[q] = *(const LAS u32x4*)(hist + lane * 16 + q * 4); s16 += hc[q].x + hc[q].y + hc[q].z + hc[q].w; }
        unsigned tot; const unsigned pre = wave_prefix_dpp(s16, tot, lane);
        const unsigned above = tot - pre;
        const bool mine = (above < (unsigned)k) && (above + s16 >= (unsigned)k);
        int B1 = 0, r = 1, m = 0;
        { unsigned c = above; bool found = false;
#pragma unroll
          for (int q = 3; q >= 0; --q) { const unsigned hb[4] = {hc[q].x, hc[q].y, hc[q].z, hc[q].w};
#pragma unroll
            for (int e = 3; e >= 0; --e) { if (!found && c + hb[e] >= (unsigned)k) { B1 = lane * 16 + q * 4 + e; r = k - (int)c; m = (int)hb[e]; found = true; } c += hb[e]; } } }
        const u64 bmn = __ballot(mine);
        const int srcl = bmn ? (int)__builtin_ctzll(bmn) : 0;
        B1 = __builtin_amdgcn_readlane(B1, srcl); r = __builtin_amdgcn_readlane(r, srcl); m = __builtin_amdgcn_readlane(m, srcl);
        if (m <= 64) {
            if (tid < 64) cand[tid] = -3.0e38f;
            __syncthreads();
#pragma unroll
            for (int j = 0; j < NV; ++j) { const float x = v[j];
                if (x >= lo && x <= hi) { int bb = (int)((x - lo) * scale); bb = bb > 1023 ? 1023 : bb;
                    if (bb == B1) { const unsigned slot = __hip_atomic_fetch_add(cnt, 1u, __ATOMIC_RELAXED, __HIP_MEMORY_SCOPE_WORKGROUP); if (slot < 64u) cand[slot] = x; } } }
            __syncthreads();
            const float c = cand[lane]; int gt = 0, ge = 0;
            const int m4 = (m + 3) >> 2;
            for (int j4 = 0; j4 < m4; ++j4) { const f32x4 cj = *(const LAS f32x4*)(cand + j4 * 4);
#pragma unroll
                for (int e = 0; e < 4; ++e) { gt += (cj[e] > c) ? 1 : 0; ge += (cj[e] >= c) ? 1 : 0; } }
            const u64 bm2 = __ballot(lane < m && gt < r && ge >= r);
            const int s2l = bm2 ? (int)__builtin_ctzll(bm2) : 0;
            thr = __int_as_float(__builtin_amdgcn_readlane(__float_as_int(c), s2l));
            break;
        } else {
            float nlo = 3.0e38f, nhi = -3.0e38f;
#pragma unroll
            for (int j = 0; j < NV; ++j) { const float x = v[j];
                if (x >= lo && x <= hi) { int bb = (int)((x - lo) * scale); bb = bb > 1023 ? 1023 : bb; if (bb == B1) { nlo = fminf(nlo, x); nhi = fmaxf(nhi, x); } } }
            nlo = wave_min_dpp(nlo); nhi = wave_max_dpp(nhi);
            if (lane == 0) { red[32 + wave] = nlo; red[40 + wave] = nhi; }
            __syncthreads();
            lo = red[32]; hi = red[40];
#pragma unroll
            for (int w = 1; w < 8; ++w) { lo = fminf(lo, red[32 + w]); hi = fmaxf(hi, red[40 + w]); }
            k = r; thr = lo;
        }
    }
    {
        int cntw = 0;
#pragma unroll
        for (int j = 0; j < NV; ++j) cntw += __popcll(__ballot((j * NTHR + tid < n) && (v[j] >= thr)));
        LAS int* wc = (LAS int*)(red + 48);
        __syncthreads();
        if (lane == 0) wc[wave] = cntw;
        __syncthreads();
        int base = 0;
        for (int w = 0; w < wave; ++w) base += wc[w];
#pragma unroll
        for (int j = 0; j < NV; ++j) { const bool sel = (j * NTHR + tid < n) && (v[j] >= thr);
            const u64 bm = __ballot(sel);
            if (sel) { const int slot = base + __popcll(bm & ((1ull << lane) - 1ull)); if (slot < 256) idxl[slot] = j * NTHR + tid; }
            base += __popcll(bm); }
    }
    __syncthreads();
    if (tid < 256) { const int idx = idxl[tid]; int ro = 0;
        if (idx >= 0) { if (idx < PAST) ro = p.page_table[b * NPG + (idx >> 7)] * PAGE + (idx & 127); else ro = -(idx - PAST + 1); }
        rowl[tid] = ro; }
    __syncthreads();
    for (int kv = 0; kv < 2; ++kv) {
    {
        const int slot = tid >> 1, dh = tid & 1; const int idx = idxl[slot]; const int ro = rowl[slot];
        float a4[4] = {0.f, 0.f, 0.f, 0.f};
        if (idx >= 0) {
            const float* kp = ((ro >= 0) ? p.cache_k + (size_t)ro * 256 : p.out + O_KS + (size_t)(b * 4 + (-ro - 1)) * 256) + kv * 128 + dh * 64;
            f32x4 kk[16];
#pragma unroll
            for (int c = 0; c < 16; ++c) kk[c] = *(const f32x4*)(kp + c * 4);
#pragma unroll
            for (int c = 0; c < 16; ++c)
#pragma unroll
                for (int h = 0; h < 4; ++h) { const f32x4 qh = *(const LAS f32x4*)(qs + (kv * 4 + h) * 128 + dh * 64 + c * 4); a4[h] += kk[c][0] * qh[0] + kk[c][1] * qh[1] + kk[c][2] * qh[2] + kk[c][3] * qh[3]; }
        }
#pragma unroll
        for (int h = 0; h < 4; ++h) { a4[h] += __shfl_xor(a4[h], 1); if (dh == 0) s2[h * 256 + slot] = idx >= 0 ? a4[h] : -3.0e38f; }
    }
    __syncthreads();
    if (wave < 4) {
        LAS float* sh = s2 + wave * 256; float x[4]; float mx = -3.0e38f;
#pragma unroll
        for (int i = 0; i < 4; ++i) { x[i] = sh[i * 64 + lane]; mx = fmaxf(mx, x[i]); }
        mx = wave_max(mx); float sum = 0.f;
#pragma unroll
        for (int i = 0; i < 4; ++i) { x[i] = (x[i] > -1.0e38f) ? __builtin_amdgcn_exp2f(x[i] - mx) : 0.f; sum += x[i]; }
        sum = wave_sum(sum); const float inv = 1.f / sum;
#pragma unroll
        for (int i = 0; i < 4; ++i) sh[i * 64 + lane] = x[i] * inv;
    }
    LAS float* Vs = (LAS float*)lds;
    { const int slot = tid >> 1, half = tid & 1; const int ro = rowl[slot];
      const float* vp = ((ro >= 0) ? p.cache_v + (size_t)ro * 256 : p.out + O_VS + (size_t)(b * 4 + (-ro - 1)) * 256) + kv * 128 + half * 64;
      f32x4 tmp[16];
#pragma unroll
      for (int c = 0; c < 16; ++c) tmp[c] = *(const f32x4*)(vp + c * 4);
#pragma unroll
      for (int c = 0; c < 16; ++c) *(LAS f32x4*)(Vs + slot * 128 + half * 64 + c * 4) = tmp[c]; }
    __syncthreads();
    { const int hl = tid >> 7, d = tid & 127, head = kv * 4 + hl; float o = 0.f;
      const LAS float* ph = s2 + hl * 256;
#pragma unroll 8
      for (int slot = 0; slot < 256; ++slot) o += ph[slot] * Vs[slot * 128 + d];
      const size_t oi = (size_t)(MP + row) * D + head * 128 + d;
      ((f16*)(p.ws + WS_AOS))[as16_off(row, head * 128 + d)] = (f16)(o * silu_f((float)((const f16*)(p.ws + WS_SG))[oi])); }
    __syncthreads();
    }
}

__device__ __forceinline__ void q_prep(h8 (&qf)[8], const float* qn, const float* ROPE, int pos, int hh) {
    float ss = 0.f;
#pragma unroll
    for (int s = 0; s < 8; ++s)
#pragma unroll
        for (int jj = 0; jj < 8; ++jj) { const float x = (float)qf[s][jj]; ss += x * x; }
    ss += __shfl_xor(ss, 32);
    const float rn = rsqrtf(ss * (1.f / 128.f) + EPS) * 0.12751743f;
    float y0[8], y1[8];
    { const f32x4 g0 = *(const f32x4*)(qn + 8 * hh), g1 = *(const f32x4*)(qn + 8 * hh + 4), g2 = *(const f32x4*)(qn + 16 + 8 * hh), g3 = *(const f32x4*)(qn + 16 + 8 * hh + 4);
#pragma unroll
      for (int jj = 0; jj < 8; ++jj) { y0[jj] = (float)qf[0][jj] * rn * (jj < 4 ? g0[jj & 3] : g1[jj & 3]); y1[jj] = (float)qf[1][jj] * rn * (jj < 4 ? g2[jj & 3] : g3[jj & 3]); } }
#pragma unroll
    for (int s = 2; s < 8; ++s)
#pragma unroll
        for (int jj = 0; jj < 8; ++jj) qf[s][jj] = (f16)((float)qf[s][jj] * rn);
    const float* rr = rope_row(ROPE, pos, 8 * hh);
    const f32x4 t0 = *(const f32x4*)rr, t1 = *(const f32x4*)(rr + 4), t2 = *(const f32x4*)(rr + 8), t3 = *(const f32x4*)(rr + 12);
    const float cs[16] = {t0[0], t0[1], t0[2], t0[3], t1[0], t1[1], t1[2], t1[3], t2[0], t2[1], t2[2], t2[3], t3[0], t3[1], t3[2], t3[3]};
#pragma unroll
    for (int jj = 0; jj < 8; ++jj) { const float c = cs[2 * jj], sn = cs[2 * jj + 1]; qf[0][jj] = (f16)(y0[jj] * c - y1[jj] * sn); qf[1][jj] = (f16)(y1[jj] * c + y0[jj] * sn); }
}

__device__ __forceinline__ float xhalf_max(float x) { const auto r = __builtin_amdgcn_permlane32_swap(__float_as_uint(x), __float_as_uint(x), false, false); return fmaxf(__uint_as_float(r[0]), __uint_as_float(r[1])); }
__device__ __forceinline__ float xhalf_sum(float x) { const auto r = __builtin_amdgcn_permlane32_swap(__float_as_uint(x), __float_as_uint(x), false, false); return __uint_as_float(r[0]) + __uint_as_float(r[1]); }
__device__ __forceinline__ void attn_tile64(const LAS f16* kb, const LAS f16* vb, unsigned mlo, unsigned mhi, const h8 (&qf)[8], f32x16 (&oacc)[4], float& mrun, float& lrun, int r, int hh) {
    constexpr int KROW = 136, VROW = 72;
    f32x16 sacc[2];
#pragma unroll
    for (int kb2 = 0; kb2 < 2; ++kb2) {
#pragma unroll
        for (int e = 0; e < 16; ++e) sacc[kb2][e] = 0.f;
#pragma unroll
        for (int s = 0; s < 8; ++s) { const h8 kf = *(const LAS h8*)(kb + (32 * kb2 + r) * KROW + 16 * s + 8 * hh); sacc[kb2] = __builtin_amdgcn_mfma_f32_32x32x16_f16(kf, qf[s], sacc[kb2], 0, 0, 0); }
    }
    float sv[32]; float mx = -3.0e38f;
#pragma unroll
    for (int kb2 = 0; kb2 < 2; ++kb2) {
        const int mwb = (int)((kb2 ? mhi : mlo) >> (4 * hh));
#pragma unroll
        for (int e = 0; e < 16; ++e) {
            const int t = __builtin_amdgcn_sbfe(mwb, (e & 3) + 8 * (e >> 2), 1);
            const int sb = (__float_as_int(sacc[kb2][e]) & t) | ((int)0xFF800000 & ~t);
            sv[16 * kb2 + e] = __int_as_float(sb); mx = fmaxf(mx, sv[16 * kb2 + e]);
        }
    }
    mx = xhalf_max(mx);
    if (__any(mx - mrun > 8.f)) {
        const float mnew = fmaxf(mrun, mx); const float alpha = __builtin_amdgcn_exp2f(mrun - mnew);
        lrun *= alpha; mrun = mnew;
#pragma unroll
        for (int mt = 0; mt < 4; ++mt)
#pragma unroll
            for (int e = 0; e < 16; ++e) oacc[mt][e] *= alpha;
    }
    float rsum = 0.f;
#pragma unroll
    for (int e = 0; e < 32; ++e) { sv[e] = __builtin_amdgcn_exp2f(sv[e] - mrun); rsum += sv[e]; }
    rsum = xhalf_sum(rsum);
    lrun += rsum;
    typedef _Float16 h2t __attribute__((ext_vector_type(2)));
    h8 pf[4];
#pragma unroll
    for (int s2 = 0; s2 < 4; ++s2)
#pragma unroll
        for (int jj = 0; jj < 4; ++jj) { const h2t pk = __builtin_bit_cast(h2t, __builtin_amdgcn_cvt_pkrtz(sv[8 * s2 + 2 * jj], sv[8 * s2 + 2 * jj + 1])); pf[s2][2 * jj] = pk[0]; pf[s2][2 * jj + 1] = pk[1]; }
#pragma unroll
    for (int mt = 0; mt < 4; ++mt)
#pragma unroll
        for (int s2 = 0; s2 < 4; ++s2) {
            const h8 vf = *(const LAS h8*)(vb + (32 * mt + r) * VROW + 16 * s2 + 8 * hh);
            oacc[mt] = __builtin_amdgcn_mfma_f32_32x32x16_f16(vf, pf[s2], oacc[mt], 0, 0, 0);
        }
}

__device__ __forceinline__ void phB_attention(CParams& p, LAS unsigned char* lds, const int wv_s) {
    const int tid = tid_fresh(), lane = tid & 63, wave = tid >> 6, r = lane & 31, hh = lane >> 5;
    const f16* Q = (const f16*)(p.ws + WS_Q); const f16* KH = (const f16*)(p.ws + WS_KH); const f16* VT = (const f16*)(p.ws + WS_VT);
    const f16* SG = (const f16*)(p.ws + WS_SG); f16* AO = (f16*)(p.ws + WS_AO); const unsigned* MASK = (const unsigned*)(p.ws + WS_MASK);
    constexpr int KROW = 136, VROW = 72;
    constexpr int KBUF = 64 * KROW, VBUF = 128 * VROW;
    LAS f16* Kb = (LAS f16*)lds;
    LAS f16* Vb = (LAS f16*)(lds + 2 * KBUF * 2);
    LAS u64* MK = (LAS u64*)(lds + 2 * KBUF * 2 + 2 * VBUF * 2) + wave * 256;
    if (blockIdx.x >= 256) return;
    for (int j = 0; j < 4; ++j) {
        const int bk = blockIdx.x & 31, b = bk >> 1, kvh = bk & 1, x = blockIdx.x >> 5;
        const int y = x & 3;
        const int qt = x < 4 ? (j == 0 ? y : (j == 1 ? 15 - y : (j == 2 ? 16 + y : 23 - y))) : (j == 0 ? 4 + y : (j == 1 ? 11 - y : (j == 2 ? 24 + y : 31 - y)));
        const int q0 = qt * 64; const size_t tok0 = (size_t)b * SEQ;
        const int query = q0 + 8 * wave + (r >> 2), head = kvh * 4 + (r & 3);
        h8 qf[8];
#pragma unroll
        for (int s = 0; s < 8; ++s) qf[s] = *(const h8*)(Q + (tok0 + query) * D + head * 128 + 16 * s + 8 * hh);
        q_prep(qf, p.q_norm, (const float*)(p.ws + WS_ROPE), query, hh);
        f32x16 oacc[4];
#pragma unroll
        for (int mt = 0; mt < 4; ++mt)
#pragma unroll
            for (int e = 0; e < 16; ++e) oacc[mt][e] = 0.f;
        float mrun = -1.0e30f, lrun = 0.f;
        const int nkt = qt + 1;
        const f16* kg = KH + (tok0 + (tid >> 4)) * 256 + kvh * 128 + (tid & 15) * 8;
        const f16* vg = VT + ((size_t)(b * 2 + kvh) * 128 + (tid >> 3)) * SEQ + (tid & 7) * 8;
        LAS f16* kl = Kb + (tid >> 4) * KROW + (tid & 15) * 8;
        LAS f16* vl = Vb + (tid >> 3) * VROW + (tid & 7) * 8;
        __syncthreads();
        h8 k0 = *(const h8*)kg, k1 = *(const h8*)(kg + (size_t)32 * 256), v0 = *(const h8*)vg, v1 = *(const h8*)(vg + (size_t)64 * SEQ);
        {
            const int mq = lane >> 3; const u64* mgq = (const u64*)(MASK + (tok0 + q0 + 8 * wave + mq) * 64);
#pragma unroll
            for (int i = 0; i < 4; ++i) { const int tl = (lane & 7) + 8 * i; if (tl < nkt) MK[mq * 32 + tl] = mgq[tl]; }
        }
        *(LAS h8*)kl = k0; *(LAS h8*)(kl + 32 * KROW) = k1; *(LAS h8*)vl = v0; *(LAS h8*)(vl + 64 * VROW) = v1;
#define AT_GLD(DST, PTR) asm volatile("global_load_dwordx4 %0, %1, off" : "=v"(DST) : "v"(PTR) : "memory")
#define AT_LOAD(K0, K1, V0, V1, T) { const int ti_ = (T) < nkt ? (T) : nkt - 1; const f16* kgn = kg + (size_t)ti_ * 64 * 256; const f16* vgn = vg + ti_ * 64; \
            AT_GLD(K0, kgn); AT_GLD(K1, kgn + (size_t)32 * 256); AT_GLD(V0, vgn); AT_GLD(V1, vgn + (size_t)64 * SEQ); }
#define AT_WAIT(N, K0, K1, V0, V1) asm volatile("s_waitcnt vmcnt(" #N ")" : "+v"(K0), "+v"(K1), "+v"(V0), "+v"(V1) :: "memory")
#define AT_STORE(K0, K1, V0, V1, BUF) { LAS f16* kl2 = kl + (BUF) * KBUF; LAS f16* vl2 = vl + (BUF) * VBUF; \
            *(LAS u32x4*)kl2 = K0; *(LAS u32x4*)(kl2 + 32 * KROW) = K1; *(LAS u32x4*)vl2 = V0; *(LAS u32x4*)(vl2 + 64 * VROW) = V1; }
        u32x4 ka0, ka1, va0, va1, kb0, kb1, vb0, vb1;
        asm volatile("s_waitcnt vmcnt(0)" ::: "memory");
        AT_LOAD(ka0, ka1, va0, va1, 1)
        AT_LOAD(kb0, kb1, vb0, vb1, 2)
        __syncthreads();
        for (int kt = 0; kt < nkt; kt += 2) {
            { const u64 mcur = MK[(r >> 2) * 32 + kt];
              attn_tile64(Kb, Vb, (unsigned)mcur, (unsigned)(mcur >> 32), qf, oacc, mrun, lrun, r, hh); }
            AT_WAIT(4, ka0, ka1, va0, va1);
            AT_STORE(ka0, ka1, va0, va1, 1)
            AT_LOAD(ka0, ka1, va0, va1, kt + 3)
            __syncthreads();
            if (kt + 1 >= nkt) break;
            { const u64 mcur = MK[(r >> 2) * 32 + kt + 1];
              attn_tile64(Kb + KBUF, Vb + VBUF, (unsigned)mcur, (unsigned)(mcur >> 32), qf, oacc, mrun, lrun, r, hh); }
            AT_WAIT(4, kb0, kb1, vb0, vb1);
            AT_STORE(kb0, kb1, vb0, vb1, 0)
            AT_LOAD(kb0, kb1, vb0, vb1, kt + 4)
            __syncthreads();
        }
        asm volatile("s_waitcnt vmcnt(0)" : "+v"(ka0), "+v"(ka1), "+v"(va0), "+v"(va1), "+v"(kb0), "+v"(kb1), "+v"(vb0), "+v"(vb1) :: "memory");
#undef AT_GLD
#undef AT_LOAD
#undef AT_WAIT
#undef AT_STORE
        const float invl = 1.f / lrun;
        const size_t obase = (tok0 + query) * D + head * 128;
#pragma unroll
        for (int mt = 0; mt < 4; ++mt)
#pragma unroll
            for (int g4 = 0; g4 < 4; ++g4) {
                const int d = 32 * mt + 8 * g4 + 4 * hh;
                const h4 sg = *(const h4*)(SG + obase + d); h4 o;
#pragma unroll
                for (int e = 0; e < 4; ++e) o[e] = (f16)(oacc[mt][4 * g4 + e] * invl * silu_f((float)sg[e]));
                *(h4*)(AO + obase + d) = o;
            }
    }
}

__device__ __forceinline__ f32x4 ld_h4f(const f16* p_) { const h4 t = *(const h4*)p_; return (f32x4){(float)t[0], (float)t[1], (float)t[2], (float)t[3]}; }
__device__ __forceinline__ void ph_conv(CParams& p, const int wv_s) {
    const f16* XB = (const f16*)(p.ws + WS_XB); f16* XC = (f16*)(p.ws + WS_XC);
    const long gtid = (long)blockIdx.x * NTHR + tid_fresh(), gth = (long)gridDim.x * NTHR;
    constexpr int RUN = 16, NRUN = MT / RUN;
    for (long it = gtid; it < (long)NRUN * 256; it += gth) {
        const int run = (int)(it >> 8), c = (int)(it & 255) * 4, row0 = run * RUN;
        const f32x4 w0 = *(const f32x4*)(p.conv_w + c), w1 = *(const f32x4*)(p.conv_w + D + c), w2 = *(const f32x4*)(p.conv_w + 2 * D + c), w3 = *(const f32x4*)(p.conv_w + 3 * D + c);
        const f32x4 bias = *(const f32x4*)(p.conv_b + c);
        const f32x4 z4 = (f32x4){0.f, 0.f, 0.f, 0.f};
        f32x4 xm1 = z4, xm2 = z4, xm3 = z4;
        if (row0 < MP) { if ((row0 & (SEQ - 1)) != 0) { xm1 = ld_h4f(XB + (size_t)(row0 - 1) * D + c); xm2 = ld_h4f(XB + (size_t)(row0 - 2) * D + c); xm3 = ld_h4f(XB + (size_t)(row0 - 3) * D + c); } }
#pragma unroll
        for (int i = 0; i < RUN; ++i) {
            const int row = row0 + i;
            const f32x4 x0 = ld_h4f(XB + (size_t)row * D + c);
            if (row < MP) { const int pos = row & (SEQ - 1);
                if (pos >= SEQ - 3) *(f32x4*)(p.out + O_CP + ((size_t)(row >> 11) * 3 + (pos - (SEQ - 3))) * D + c) = x0;
            } else { const int rs = row - MP, b = rs >> 2, t = rs & 3;
                if (t == 0) { const float* st = p.st_conv + (size_t)b * 3 * D + c; xm3 = *(const f32x4*)st; xm2 = *(const f32x4*)(st + D); xm1 = *(const f32x4*)(st + 2 * D); }
                else *(f32x4*)(p.out + O_CS + ((size_t)b * 3 + (t - 1)) * D + c) = x0;
            }
            const f32x4 y = w3 * x0 + w2 * xm1 + w1 * xm2 + w0 * xm3 + bias;
            *(h4*)(XC + (size_t)row * D + c) = to_h4(y);
            if (row >= MP) *(h4*)((f16*)(p.ws + WS_XCS) + as16_off(row - MP, c)) = to_h4(y);
            xm3 = xm2; xm2 = xm1; xm1 = x0;
        }
    }
}

__device__ __forceinline__ void ph_scanA(CParams& p, const int wv_s) {
    const unsigned* LB = (const unsigned*)(p.ws + WS_LA); float* TOT = (float*)(p.ws + WS_TOT);
    const long gtid = (long)blockIdx.x * NTHR + tid_fresh(), gth = (long)gridDim.x * NTHR;
    for (long it = gtid; it < (long)NB * 16 * D; it += gth) {
        const int ch = (int)(it & 1023), chunk = (int)(it >> 10) & 15, b = (int)(it >> 14);
        if (chunk == 15) continue;
        const size_t base = ((size_t)b * SEQ + chunk * 128) * D + ch;
        float Ap = 1.f, h = 0.f;
#pragma unroll 16
        for (int t = 0; t < 128; ++t) { float a, bb; unpack_lb(LB[base + (size_t)t * D], a, bb); Ap *= a; h = a * h + bb; }
        TOT[(((size_t)b * 16 + chunk) * D + ch) * 2] = Ap; TOT[(((size_t)b * 16 + chunk) * D + ch) * 2 + 1] = h;
    }
}

__device__ __forceinline__ void ph_scanB(CParams& p, const int wv_s) {
    const unsigned* LB = (const unsigned*)(p.ws + WS_LA); const float* TOT = (const float*)(p.ws + WS_TOT);
    const f16* G1 = (const f16*)(p.ws + WS_G1); f16* U = (f16*)(p.ws + WS_U);
    const long gtid = (long)blockIdx.x * NTHR + tid_fresh(), gth = (long)gridDim.x * NTHR;
    for (long it = gtid; it < (long)NB * 16 * D + DB * D; it += gth) {
        if (it < (long)NB * 16 * D) {
            const int ch = (int)(it & 1023), chunk = (int)(it >> 10) & 15, b = (int)(it >> 14);
            float h = 0.f;
            for (int c2 = 0; c2 < chunk; ++c2) { const f32x2 ab = *(const f32x2*)(TOT + (((size_t)b * 16 + c2) * D + ch) * 2); h = ab[0] * h + ab[1]; }
            const size_t base = ((size_t)b * SEQ + chunk * 128) * D + ch;
#pragma unroll 16
            for (int t = 0; t < 128; ++t) { const size_t o = base + (size_t)t * D; float a, bb; unpack_lb(LB[o], a, bb); h = a * h + bb; U[o] = (f16)(h * (float)G1[o]); }
            if (chunk == 15) p.out[O_HP + (size_t)b * D + ch] = h;
        } else {
            const int i2 = (int)(it - (long)NB * 16 * D); const int ch = i2 & 1023, b = i2 >> 10;
            float h = p.st_h[(size_t)b * D + ch];
            const size_t base = ((size_t)MP + b * 4) * D + ch;
#pragma unroll
            for (int t = 0; t < 4; ++t) { const size_t o = base + (size_t)t * D; float a, bb; unpack_lb(LB[o], a, bb); h = a * h + bb; ((f16*)(p.ws + WS_US))[as16_off(b * 4 + t, ch)] = (f16)(h * (float)G1[o]); }
            p.out[O_HS + (size_t)b * D + ch] = h;
        }
    }
}

template <class ORDER> __device__ __forceinline__ void ph_gates_prep(CParams& p, const ORDER& S, const int wv_s) {
    const int tid = tid_fresh();
    f16* XC = (f16*)(p.ws + WS_XC); const float* XCH = (const float*)(p.ws + WS_XCH); const float* XBT = (const float*)(p.ws + WS_XBT);
    pg::Unit u;
    for (int i = 0; S.next(i, u); ++i) {
        const int pm = u.pm, blk = u.pn >> 1;
        if ((pm & 7) == 0) continue;
        for (int e = tid; e < 768; e += NTHR) {
            const int r = e >> 8, c = blk * 256 + (e & 255);
            const float* t = XBT + (size_t)(pm - 1) * 3 * D + c;
            const float w0 = p.conv_w[c], w1 = p.conv_w[D + c], w2 = p.conv_w[2 * D + c];
            float y = XCH[((size_t)pm * 3 + r) * D + c];
            if (r == 0) y += w2 * t[2 * D] + w1 * t[D] + w0 * t[0]; else if (r == 1) y += w1 * t[2 * D] + w0 * t[D]; else y += w0 * t[2 * D];
            XC[((size_t)pm * 256 + r) * D + c] = (f16)y;
        }
    }
    const f16* XB = (const f16*)(p.ws + WS_XB);
    for (int un = (int)blockIdx.x; un < 64; un += (int)gridDim.x) {
        const int blk = un >> 4;
        for (int it = tid; it < DB * 64; it += NTHR) {
            const int b = it >> 6, c = blk * 256 + (it & 63) * 4;
            const f32x4 w0 = *(const f32x4*)(p.conv_w + c), w1 = *(const f32x4*)(p.conv_w + D + c), w2 = *(const f32x4*)(p.conv_w + 2 * D + c), w3 = *(const f32x4*)(p.conv_w + 3 * D + c);
            const f32x4 bias = *(const f32x4*)(p.conv_b + c);
            const float* st = p.st_conv + (size_t)b * 3 * D + c;
            f32x4 xm3 = *(const f32x4*)st, xm2 = *(const f32x4*)(st + D), xm1 = *(const f32x4*)(st + 2 * D);
#pragma unroll
            for (int t = 0; t < 4; ++t) {
                const int rs = b * 4 + t;
                const f32x4 x0 = ld_h4f(XB + (size_t)(MP + rs) * D + c);
                if (t > 0) *(f32x4*)(p.out + O_CS + ((size_t)b * 3 + (t - 1)) * D + c) = x0;
                const f32x4 y = w3 * x0 + w2 * xm1 + w1 * xm2 + w0 * xm3 + bias;
                *(h4*)(XC + (size_t)(MP + rs) * D + c) = to_h4(y);
                *(h4*)((f16*)(p.ws + WS_XCS) + as16_off(rs, c)) = to_h4(y);
                xm3 = xm2; xm2 = xm1; xm1 = x0;
            }
        }
    }
    asm volatile("s_waitcnt vmcnt(0)" ::: "memory");
    __syncthreads();
}

__device__ __forceinline__ void ph_scan(CParams& p, LAS unsigned char* lds, const int wv_s) {
    const unsigned* LB = (const unsigned*)(p.ws + WS_LA);
    const f16* G1 = (const f16*)(p.ws + WS_G1); f16* U = (f16*)(p.ws + WS_U);
    const int tid = tid_fresh();
    const int chunk = tid >> 3, quad = tid & 7;
    LAS float* AG = (LAS float*)lds;
    LAS float* CR = (LAS float*)(lds + 16384);
    constexpr float KL = 0.015625f * 1.44269504f;
    const int nk = ((NB * 32 - (int)blockIdx.x + (int)gridDim.x - 1) / (int)gridDim.x) * 2;
    auto base_of = [](int k, int chunk, int quad) -> size_t { const int item = (int)blockIdx.x + (k >> 1) * (int)gridDim.x; return ((size_t)(item >> 5) * SEQ + (k & 1) * 1024 + chunk * 16) * D + (item & 31) * 32 + quad * 4; };
    u32x4 lbv[16], nlb[16]; h4 gv[16];
    if (nk > 0) { const unsigned* lbp = LB + base_of(0, chunk, quad);
#pragma unroll
        for (int i = 0; i < 16; ++i) lbv[i] = *(const u32x4*)(lbp + (size_t)i * D); }
    float hc = 0.f;
    for (int k = 0; k < nk; ++k) {
        const size_t base = base_of(k, chunk, quad);
        const f16* gp = G1 + base; f16* up = U + base;
        asm volatile("" : "+v"(gp), "+v"(up));
#pragma unroll
        for (int i = 0; i < 16; ++i) gv[i] = *(const h4*)(gp + (size_t)i * D);
        if (k + 1 < nk) { const unsigned* lbp = LB + base_of(k + 1, chunk, quad);
#pragma unroll
            for (int i = 0; i < 16; ++i) nlb[i] = *(const u32x4*)(lbp + (size_t)i * D); }
        f32x4 ls = {0.f, 0.f, 0.f, 0.f}, h = {0.f, 0.f, 0.f, 0.f};
#pragma unroll
        for (int i = 0; i < 16; ++i)
#pragma unroll
            for (int e = 0; e < 4; ++e) { const unsigned w = lbv[i][e]; const h2v t = __builtin_bit_cast(h2v, w); const float l = (float)t[0]; ls[e] += l; h[e] = __builtin_amdgcn_exp2f(l * KL) * h[e] + (float)t[1]; }
        { LAS f32x4* ag = (LAS f32x4*)(AG + (size_t)tid * 8);
          ag[0] = (f32x4){__builtin_amdgcn_exp2f(ls[0] * KL), h[0], __builtin_amdgcn_exp2f(ls[1] * KL), h[1]};
          ag[1] = (f32x4){__builtin_amdgcn_exp2f(ls[2] * KL), h[2], __builtin_amdgcn_exp2f(ls[3] * KL), h[3]}; }
        __syncthreads();
        if (tid < 32) {
            if ((k & 1) == 0) hc = 0.f;
#pragma unroll
            for (int c = 0; c < 64; ++c) { const f32x2 ah = *(LAS f32x2*)(AG + (c * 32 + tid) * 2); CR[c * 32 + tid] = hc; hc = ah[0] * hc + ah[1]; }
            if (k & 1) { const int item = (int)blockIdx.x + (k >> 1) * (int)gridDim.x; p.out[O_HP + (size_t)(item >> 5) * D + (item & 31) * 32 + tid] = hc; }
        }
        __syncthreads();
        f32x4 hh = *(LAS f32x4*)(CR + (size_t)tid * 4);
#pragma unroll
        for (int i = 0; i < 16; ++i) asm volatile("" : "+v"(lbv[i]));
#pragma unroll
        for (int i = 0; i < 16; ++i) {
            h4 u;
#pragma unroll
            for (int e = 0; e < 4; ++e) { const unsigned w = lbv[i][e]; const h2v t = __builtin_bit_cast(h2v, w); hh[e] = __builtin_amdgcn_exp2f((float)t[0] * KL) * hh[e] + (float)t[1]; u[e] = (f16)(hh[e] * (float)gv[i][e]); }
            *(h4*)(up + (size_t)i * D) = u;
        }
#pragma unroll
        for (int i = 0; i < 16; ++i) lbv[i] = nlb[i];
        __syncthreads();
    }
    const long gtid = (long)blockIdx.x * NTHR + tid, gth = (long)gridDim.x * NTHR;
    for (long it = gtid; it < (long)DB * D; it += gth) {
        const int ch = (int)it & 1023, b = (int)(it >> 10);
        float h = p.st_h[(size_t)b * D + ch];
        const size_t base = ((size_t)MP + b * 4) * D + ch;
#pragma unroll
        for (int t = 0; t < 4; ++t) { const size_t o = base + (size_t)t * D; float a, bb; unpack_lb(LB[o], a, bb); h = a * h + bb; ((f16*)(p.ws + WS_US))[as16_off(b * 4 + t, ch)] = (f16)(h * (float)G1[o]); }
        p.out[O_HS + (size_t)b * D + ch] = h;
    }
}

constexpr int NPHASE = 14;
extern __shared__ __attribute__((aligned(16))) unsigned char dyn_lds[];

#define PHASE_PARAMS() CParams* kp_ = (CParams*)__builtin_amdgcn_kernarg_segment_ptr(); asm volatile("" : "+s"(kp_)); CParams& p = *kp_; \
    float* ADA = (float*)(p.ws + WS_ADA); f16* H = (f16*)(p.ws + WS_H); float* X1 = (float*)(p.ws + WS_X1); (void)ADA; (void)H; (void)X1;
__global__ void __launch_bounds__(NTHR, 2) fwd_kernel(Params p_arg) {
    LAS unsigned char* lds = (LAS unsigned char*)dyn_lds;
    const int wv_s = __builtin_amdgcn_readfirstlane((int)(threadIdx.x >> 6));
#if N_LAUNCH_MODE == 1
    const int lo = 0, hi = NPHASE; (void)p_arg;
    if (threadIdx.x == 0) *(LAS u32x4*)(lds + LDS_BARW) = (u32x4){0u, 0u, 0u, 0u};
    __syncthreads();
    XcdBarrier bar = xcd_barrier_post((unsigned*)(p_arg.ws + WS_CTL), (volatile LAS unsigned*)(lds + LDS_BARW));
#define SEAM(k) do { if ((k) + 1 < hi) xcd_barrier(bar); } while (0)
#else
    const int lo = (int)p_arg.ph_lo, hi = (int)p_arg.ph_hi;
#define SEAM(k) do { } while (0)
#endif
#ifndef PH_MASK
#define PH_MASK 0xFFFF
#endif
#define IN(k) ((((PH_MASK) >> (k)) & 1) && lo <= (k) && (k) < hi)
#ifndef DUP_MASK
#define DUP_MASK 0
#endif
#define DUPQ(k) ((((DUP_MASK) >> (k)) & 1) != 0)

    if (IN(0)) { PHASE_PARAMS(); ph0_prologue(p, lds, wv_s); if (DUPQ(0)) { ph0_prologue(p, lds, wv_s); } SEAM(0); }
    if (IN(1)) { PHASE_PARAMS(); ph_modulate(p.x_p, p.x_s, p.norm_g, ADA, H, (f16*)(p.ws + WS_HS), wv_s);
        {
            f16* SHS = (f16*)(p.ws + WS_SHS); const long gtid = (long)blockIdx.x * NTHR + tid_fresh(), gth = (long)gridDim.x * NTHR;
            for (long e = gtid; e < 128 * D; e += gth) { const int r = (int)(e >> 10), k = (int)(e & 1023); SHS[as16_off(r, k)] = r < 48 ? (f16)ADA[((size_t)48 + r) * 3072 + k] : (f16)0.f; }
        }
        SEAM(1); }
    if (IN(2)) { PHASE_PARAMS();
        const EmitInproj em{(f16*)(p.ws + WS_Q), (f16*)(p.ws + WS_QI), (f16*)(p.ws + WS_SG), (f16*)(p.ws + WS_VT), (float*)(p.ws + WS_WI), p.out};
        {
            const int G = (int)gridDim.x, rem = (MP / 256 * (NIN / 256)) % G, lo = rem == 0 ? 0 : rem;
            thin_gemm(lds, (const f16*)(p.ws + WS_HS), (const f16*)(p.ws + WS_WIN), D, NIN, em, wv_s, lo, G - lo);
            thin_gemm(lds, (const f16*)(p.ws + WS_SHS), (const f16*)(p.ws + WS_WLIN), D, 2 * D, EmitSW{(float*)(p.ws + WS_SW)}, wv_s, lo, G - lo);
        }
        pg::Gemm g{H, (const f16*)(p.ws + WS_WIN), D, D, D};
        pg::GridOrder<MapFull> S; S.init(MP / 256, NIN / 256, (int)gridDim.x, (int)blockIdx.x, MapFull{D, D});
        const EpiMain<EmitInproj> E{em};
        pg::gemm_phase(lds, g, S, E, wv_s); if (DUPQ(2)) { pg::gemm_phase(lds, g, S, E, wv_s); } if (DUPQ(18)) { const EpiMain<EmitNull> EN{EmitNull{}}; pg::gemm_phase(lds, g, S, EN, wv_s); }
        SEAM(2);
    }
    if (IN(3)) { PHASE_PARAMS(); ph3_fixup(p, wv_s); SEAM(3); }
    if (IN(4)) { PHASE_PARAMS(); if (wv_s < 4) { phA_sample(p, lds, wv_s); phA_prompt<true>(p, lds, wv_s); } else { phA_prompt<true>(p, lds, wv_s); phA_sample(p, lds, wv_s); }     if (DUPQ(15)) { phA_sample(p, lds, wv_s); } if (DUPQ(16)) { phA_prompt<true>(p, lds, wv_s); } if (DUPQ(17)) { phA_prompt<false>(p, lds, wv_s); } SEAM(4); }
    if (IN(5)) { PHASE_PARAMS(); phB_sample(p, lds, wv_s); phB_attention(p, lds, wv_s); if (DUPQ(5)) { phB_sample(p, lds, wv_s); } if (DUPQ(14)) { phB_attention(p, lds, wv_s); } SEAM(5); }
    if (IN(6)) { PHASE_PARAMS();
        const float* ADA1 = ADA + (size_t)48 * 3072;
        const EmitResidHS ems{p.x_s, ADA, ADA1, p.norm_g + D, X1 + (size_t)MP * D, (f16*)(p.ws + WS_HS), (float*)(p.ws + WS_SSPS)};
        thin_gemm(lds, (const f16*)(p.ws + WS_AOS), (const f16*)(p.ws + WS_WO0), D, D, ems, wv_s);
        pg::Gemm g{(const f16*)(p.ws + WS_AO), (const f16*)(p.ws + WS_WO0), D, D, D};
        pg::GridOrder<MapFull> S; S.init(MP / 256, D / 256, (int)gridDim.x, (int)blockIdx.x, MapFull{D, D});
        const EpiResidH E{p.x_p, ADA, ADA1, p.norm_g + D, X1, H, (float*)(p.ws + WS_SSP)};
        pg::gemm_phase(lds, g, S, E, wv_s); if (DUPQ(6)) { pg::gemm_phase(lds, g, S, E, wv_s); }
        SEAM(6);
    }
    if (IN(8)) { PHASE_PARAMS();
        const EmitLruIn em{(f16*)(p.ws + WS_XB), (f16*)(p.ws + WS_G1), (const float*)(p.ws + WS_SSPS), (const float*)(p.ws + WS_SW)};
        thin_gemm(lds, (const f16*)(p.ws + WS_HS), (const f16*)(p.ws + WS_WLIN), D, 2 * D, em, wv_s);
        pg::Gemm g{H, (const f16*)(p.ws + WS_WLIN), D, D, D};
        pg::GridOrder<MapFull> S; S.init(MP / 256, 2 * D / 256, (int)gridDim.x, (int)blockIdx.x, MapFull{D, D});
        const EpiLruIn E{em, (f16*)(p.ws + WS_XC), (float*)(p.ws + WS_XCH), (float*)(p.ws + WS_XBT), p.out, p.conv_w, p.conv_b, lds, (const float*)(p.ws + WS_SSP), (const float*)(p.ws + WS_SW)};
        pg::gemm_phase(lds, g, S, E, wv_s); if (DUPQ(8)) { pg::gemm_phase(lds, g, S, E, wv_s); }
        SEAM(8);
    }
    if (IN(10)) { PHASE_PARAMS();
        const EmitGates em{(const f16*)(p.ws + WS_XC), p.b_a, p.b_x, (const float*)(p.ws + WS_LS), (unsigned*)(p.ws + WS_LA)};
        pg::Gemm g{(const f16*)(p.ws + WS_XC), (const f16*)(p.ws + WS_WG), D, 256, 256};
        pg::GridOrder<MapGates> S; S.init(MP / 256, 8, (int)gridDim.x, (int)blockIdx.x, MapGates{});
        ph_gates_prep(p, S, wv_s);
        thin_gemm_gates(lds, (const f16*)(p.ws + WS_XCS), (const f16*)(p.ws + WS_WG), em, wv_s);
        const EpiGates E{em};
        pg::gemm_phase(lds, g, S, E, wv_s); if (DUPQ(10)) { pg::gemm_phase(lds, g, S, E, wv_s); }
        SEAM(10);
    }
    if (IN(11)) { PHASE_PARAMS(); ph_scan(p, lds, wv_s); if (DUPQ(11)) { ph_scan(p, lds, wv_s); } SEAM(11); }
    if (IN(13)) { PHASE_PARAMS();
        const EmitResid em{X1, X1 + (size_t)MP * D, ADA + (size_t)48 * 3072, p.out + O_Y, p.out + O_YS};
        thin_gemm(lds, (const f16*)(p.ws + WS_US), (const f16*)(p.ws + WS_WLO), D, D, em, wv_s);
        pg::Gemm g{(const f16*)(p.ws + WS_U), (const f16*)(p.ws + WS_WLO), D, D, D};
        pg::GridOrder<MapFull> S; S.init(MP / 256, D / 256, (int)gridDim.x, (int)blockIdx.x, MapFull{D, D});
        const EpiMain<EmitResid> E{em};
        pg::gemm_phase(lds, g, S, E, wv_s); if (DUPQ(13)) { pg::gemm_phase(lds, g, S, E, wv_s); }
    }
#undef IN
#undef SEAM
}

extern "C" void kernel_launch(void* const* d_in, const int* in_sizes, int n_in, void* d_out, int out_size, void* d_ws, size_t ws_size, hipStream_t stream) {
    static int grid = 0;
    if (grid == 0) {
        if (n_in != 26 || (size_t)out_size != O_END || ws_size < WS_END) { fprintf(stderr, "kernel_launch: unexpected shapes: n_in %d out %d (want %zu) ws %zu (want %zu)\n", n_in, out_size, (size_t)O_END, ws_size, (size_t)WS_END); grid = -1; return; }
        int dev = 0, cus = 0, per_cu = 0;
        if (hipGetDevice(&dev) != hipSuccess || hipDeviceGetAttribute(&cus, hipDeviceAttributeMultiprocessorCount, dev) != hipSuccess) { grid = -1; return; }
        if (hipFuncSetAttribute((const void*)fwd_kernel, hipFuncAttributeMaxDynamicSharedMemorySize, LDS_BYTES) != hipSuccess) { fprintf(stderr, "kernel_launch: hipFuncSetAttribute failed\n"); grid = -1; return; }
        if (hipOccupancyMaxActiveBlocksPerMultiprocessor(&per_cu, (const void*)fwd_kernel, NTHR, LDS_BYTES) != hipSuccess || per_cu < 1)
            fprintf(stderr, "kernel_launch: occupancy query reports %d blocks per CU\n", per_cu);
        (void)hipGetLastError();
        grid = cus < 256 ? cus : 256;
    }
    if (grid < 0) return;
    (void)hipMemsetAsync((char*)d_ws + WS_CTL, 0, 65536, stream);
    Params p{};
    p.x_p = (const float*)d_in[0]; p.x_s = (const float*)d_in[1]; p.cache_k = (const float*)d_in[2]; p.cache_v = (const float*)d_in[3]; p.cache_ik = (const float*)d_in[4];
    p.st_conv = (const float*)d_in[5]; p.st_h = (const float*)d_in[6]; p.page_table = (const int*)d_in[7]; p.c_p = (const float*)d_in[8]; p.c_s = (const float*)d_in[9];
    p.norm_g = (const float*)d_in[10]; p.ada_w = (const float*)d_in[11]; p.ada_b = (const float*)d_in[12]; p.w_in = (const float*)d_in[13]; p.q_norm = (const float*)d_in[14];
    p.k_norm = (const float*)d_in[15]; p.w_out0 = (const float*)d_in[16]; p.lw_in = (const float*)d_in[17]; p.conv_w = (const float*)d_in[18]; p.conv_b = (const float*)d_in[19];
    p.w_a = (const float*)d_in[20]; p.b_a = (const float*)d_in[21]; p.w_x = (const float*)d_in[22]; p.b_x = (const float*)d_in[23]; p.lam = (const float*)d_in[24]; p.lw_out = (const float*)d_in[25];
    p.out = (float*)d_out; p.ws = (unsigned char*)d_ws;
#if N_LAUNCH_MODE == 1
    p.ph_lo = 0; p.ph_hi = NPHASE;
    hipLaunchKernelGGL(fwd_kernel, dim3(grid), dim3(NTHR), LDS_BYTES, stream, p);
#else
    for (int k = 0; k < NPHASE; ++k) { p.ph_lo = k; p.ph_hi = k + 1; hipLaunchKernelGGL(fwd_kernel, dim3(grid), dim3(NTHR), LDS_BYTES, stream, p); }
#endif
    const hipError_t le = hipPeekAtLastError();
    if (le != hipSuccess) fprintf(stderr, "kernel_launch: launch failed: %s\n", hipGetErrorName(le));
}
```

```cpp
#include <hip/hip_runtime.h>
#include <stdint.h>
#include <stdio.h>

#define DUP_MASK 0
#ifndef N_LAUNCH_MODE
#define N_LAUNCH_MODE 1
#endif

#define LAS __attribute__((address_space(3)))
typedef _Float16 f16;
typedef _Float16 h8 __attribute__((ext_vector_type(8)));
typedef _Float16 h4 __attribute__((ext_vector_type(4)));
typedef float f32x2 __attribute__((ext_vector_type(2)));
typedef float f32x4 __attribute__((ext_vector_type(4)));
typedef float f32x16 __attribute__((ext_vector_type(16)));
typedef unsigned long long u64;
typedef unsigned u32x4 __attribute__((ext_vector_type(4)));

constexpr int D = 1024, NB = 16, SEQ = 2048, MP = NB * SEQ, DB = 32, DT = 4, MS = DB * DT, MT = MP + MS, MPAD = 33024;
constexpr int PAST = 16384, PAGE = 128, NPG = 128, LSP = 16400;
constexpr int NIN = 3840;
constexpr float EPS = 1e-6f;
constexpr int NTHR = 512;

constexpr size_t O_Y = 0, O_YS = O_Y + (size_t)MP * D, O_K = O_YS + (size_t)MS * D, O_V = O_K + (size_t)MP * 256, O_IK = O_V + (size_t)MP * 256,
                 O_KS = O_IK + (size_t)MP * 64, O_VS = O_KS + (size_t)MS * 256, O_IKS = O_VS + (size_t)MS * 256, O_CP = O_IKS + (size_t)MS * 64,
                 O_HP = O_CP + (size_t)NB * 3 * D, O_CS = O_HP + (size_t)NB * D, O_HS = O_CS + (size_t)DB * 3 * D, O_END = O_HS + (size_t)DB * D;

constexpr size_t al256(size_t x) { return (x + 255) & ~(size_t)255; }
constexpr size_t WS_REG = (size_t)MPAD * D * 2;
constexpr size_t WS_CTL = 0, WS_WIN = 65536, WS_WO0 = WS_WIN + al256((size_t)NIN * D * 2), WS_WLIN = WS_WO0 + (size_t)D * D * 2, WS_WG = WS_WLIN + (size_t)2 * D * D * 2,
                 WS_WLO = WS_WG + (size_t)2048 * 256 * 2, WS_ADA = WS_WLO + (size_t)D * D * 2, WS_R0 = WS_ADA + al256((size_t)2 * 48 * 3072 * 4),
                 WS_R1 = WS_R0 + WS_REG, WS_R2 = WS_R1 + WS_REG, WS_R3 = WS_R2 + WS_REG,
                 WS_H = WS_R0, WS_LA = WS_R0, WS_Q = WS_R1, WS_XB = WS_R1, WS_QI = WS_R2, WS_AO = WS_R2, WS_XC = WS_R2, WS_U = WS_R2, WS_SG = WS_R3, WS_G1 = WS_R3,
                 WS_KH = WS_R3 + WS_REG, WS_VT = WS_KH + (size_t)MPAD * 256 * 2, WS_KIH = WS_VT + (size_t)NB * 2 * 128 * SEQ * 2,
                 WS_WI = WS_KIH + (size_t)MPAD * 64 * 2, WS_MASK = WS_WI + (size_t)MPAD * 16 * 4, WS_SCS = WS_MASK + (size_t)MP * 64 * 4,
                 WS_X1 = WS_SCS + al256((size_t)MS * LSP * 4), WS_TOT = WS_X1 + (size_t)MPAD * D * 4,
                 WS_HS = WS_TOT + (size_t)NB * 16 * D * 2 * 4, WS_AOS = WS_HS + 262144, WS_XCS = WS_AOS + 262144, WS_US = WS_XCS + 262144, WS_ROPE = WS_US + 262144, WS_LS = WS_ROPE + al256((size_t)(SEQ + DT) * 24 * 2 * 4), WS_XBT = WS_LS + 4096, WS_SSP = WS_XBT + (size_t)(MP / 256) * 3 * D * 4, WS_SSPS = WS_SSP + (size_t)MP * 16 * 4, WS_SW = WS_SSPS + (size_t)MS * 64 * 4,
                 WS_SHS = WS_SW + (size_t)48 * 2 * D * 4, WS_END = WS_SHS + 262144;
constexpr size_t WS_XCH = WS_TOT;

constexpr int LDS_STAGE = 131072, LDS_AUX = 131072, LDS_BARW = 147456, LDS_BYTES = 147472;

__constant__ double INV32[16] = {1.0, 0.4403666026717805, 0.1939227447486858, 0.08539710028576561, 0.03760603093086394, 0.016560440080994443, 0.007292664737217109,
                                 0.0032114459947525913, 0.0014142135623730955, 0.0006227724219145962, 0.00027424817567620724, 0.00012076973741146502,
                                 5.318295896944988e-05, 2.3419998961409345e-05, 1.0313385377212461e-05, 4.541670480607871e-06};
__constant__ double INV16[8] = {1.0, 0.1939227447486858, 0.03760603093086394, 0.007292664737217109, 0.0014142135623730955, 0.00027424817567620724,
                                5.318295896944988e-05, 1.0313385377212461e-05};

struct Params {
    const float *x_p, *x_s, *cache_k, *cache_v, *cache_ik, *st_conv, *st_h;
    const int* page_table;
    const float *c_p, *c_s, *norm_g, *ada_w, *ada_b, *w_in, *q_norm, *k_norm, *w_out0, *lw_in, *conv_w, *conv_b, *w_a, *b_a, *w_x, *b_x, *lam, *lw_out;
    float* out;
    unsigned char* ws;
    long ph_lo, ph_hi;
};

typedef const Params __attribute__((address_space(4))) CParams;

#define XB_TMO      128
#define XB_XCNT(j)  (256  + 64 * (j))
#define XB_XSUB(j)  (1280 + 64 * (j))
#define XB_XGEN(j)  (2304 + 64 * (j))
#define XB_TOP      3328
#define XB_TOPGEN   3392
#define XCD_BAR_WORDS 3456
#define XB_SPIN_CAP (1u << 22)

__device__ __forceinline__ unsigned xb_ld(unsigned* p)              { return __hip_atomic_load(p, __ATOMIC_RELAXED, __HIP_MEMORY_SCOPE_AGENT); }
__device__ __forceinline__ unsigned xb_add(unsigned* p, unsigned v) { return __hip_atomic_fetch_add(p, v, __ATOMIC_RELAXED, __HIP_MEMORY_SCOPE_AGENT); }
__device__ __forceinline__ unsigned xb_xcc_id() { return (unsigned)__builtin_amdgcn_s_getreg((3 << 11) | 20) & 0xFu; }
#define XB_SPIN(cond, bar) do { unsigned _sp = 0; while (cond) { __builtin_amdgcn_s_sleep(1); \
    if ((++_sp & 255u) == 0u) { if (xb_ld(&(bar)[XB_TMO])) break; if (_sp > XB_SPIN_CAP) { atomicAdd(&(bar)[XB_TMO], 1u); break; } } } } while (0)

struct XcdBarrier { unsigned* bar; unsigned x; volatile LAS unsigned* st; };

__device__ __forceinline__ XcdBarrier xcd_barrier_post(unsigned* bar, volatile LAS unsigned* st) {
    XcdBarrier b; b.bar = bar; b.x = xb_xcc_id(); b.st = st;
    if (threadIdx.x == 0) (void)xb_add(&bar[XB_XCNT(b.x)], 1u);
    return b;
}
__device__ __forceinline__ void xcd_barrier_complete(unsigned* bar, unsigned x, unsigned& nloc, unsigned& nx) {
    const unsigned G = gridDim.x * gridDim.y * gridDim.z;
    unsigned sum, cnt, mine, sp = 0u;
    for (;;) {
        sum = 0u; cnt = 0u; mine = 0u;
#pragma unroll
        for (unsigned j = 0; j < 16; ++j) { const unsigned c = xb_ld(&bar[XB_XCNT(j)]); sum += c; cnt += (c > 0u) ? 1u : 0u; mine = (j == x) ? c : mine; }
        if (sum == G) break;
        __builtin_amdgcn_s_sleep(1);
        if ((++sp & 255u) == 0u) { if (xb_ld(&bar[XB_TMO])) break; if (sp > XB_SPIN_CAP) { atomicAdd(&bar[XB_TMO], 1u); break; } }
    }
    nloc = mine > 0u ? mine : 1u; nx = cnt > 0u ? cnt : 1u;
}
__device__ __forceinline__ void xcd_barrier(const XcdBarrier& b) {
    asm volatile("s_waitcnt vmcnt(0)" ::: "memory");
    __syncthreads();
    if (threadIdx.x == 0) {
        unsigned* bar = b.bar;
        __builtin_amdgcn_s_waitcnt(0);
        unsigned nloc = b.st[0], nx = b.st[1];
        if (nloc == 0u) { xcd_barrier_complete(bar, b.x, nloc, nx); b.st[0] = nloc; b.st[1] = nx; }
        const unsigned old = xb_add(&bar[XB_XSUB(b.x)], 1u);
        const unsigned gen = old / nloc;
        if (old + 1u == (gen + 1u) * nloc) {
            __builtin_amdgcn_fence(__ATOMIC_RELEASE, "agent");
            asm volatile("s_waitcnt vmcnt(0)" ::: "memory");
            const unsigned og = xb_add(&bar[XB_TOP], 1u);
            const unsigned tg = og / nx;
            if (og + 1u == (tg + 1u) * nx) xb_add(&bar[XB_TOPGEN], 1u);
            else XB_SPIN(xb_ld(&bar[XB_TOPGEN]) == tg, bar);
            __builtin_amdgcn_fence(__ATOMIC_ACQUIRE, "agent");
            xb_add(&bar[XB_XGEN(b.x)], 1u);
            asm volatile("s_waitcnt vmcnt(0)" ::: "memory");
        } else {
            XB_SPIN(xb_ld(&bar[XB_XGEN(b.x)]) == gen, bar);
            __builtin_amdgcn_fence(__ATOMIC_ACQUIRE, "agent");
            asm volatile("s_waitcnt vmcnt(0)" ::: "memory");
        }
    }
    __syncthreads();
}

#define WSYNC() asm volatile("s_waitcnt lgkmcnt(0)" ::: "memory")
__device__ __forceinline__ int tid_fresh_(int wv_s) { int l; asm volatile("v_mbcnt_lo_u32_b32 %0, -1, 0\n\tv_mbcnt_hi_u32_b32 %0, -1, %0" : "=v"(l)); return wv_s * 64 + l; }
#define tid_fresh() tid_fresh_(wv_s)
__device__ __forceinline__ float wave_sum(float v) {
#pragma unroll
    for (int o = 32; o > 0; o >>= 1) v += __shfl_xor(v, o);
    return v;
}
__device__ __forceinline__ float wave_max(float v) {
#pragma unroll
    for (int o = 32; o > 0; o >>= 1) v = fmaxf(v, __shfl_xor(v, o));
    return v;
}
__device__ __forceinline__ float wave_min(float v) {
#pragma unroll
    for (int o = 32; o > 0; o >>= 1) v = fminf(v, __shfl_xor(v, o));
    return v;
}
__device__ __forceinline__ float relu_f(float x) { const int b = __builtin_bit_cast(int, x); return __builtin_bit_cast(float, b > 0 ? b : 0); }
__device__ __forceinline__ float silu_f(float v) { return v * __builtin_amdgcn_rcpf(1.f + __expf(-v)); }
__device__ __forceinline__ float sigmoid_f(float v) { return __builtin_amdgcn_rcpf(1.f + __expf(-v)); }
__device__ __forceinline__ h4 to_h4(f32x4 v) { h4 r; r[0] = (f16)v[0]; r[1] = (f16)v[1]; r[2] = (f16)v[2]; r[3] = (f16)v[3]; return r; }
typedef _Float16 h2v __attribute__((ext_vector_type(2)));
__device__ __forceinline__ unsigned pack_lb(float l, float b) { h2v t; t[0] = (f16)(l * 64.f); t[1] = (f16)b; return __builtin_bit_cast(unsigned, t); }
__device__ __forceinline__ void unpack_lb(unsigned w, float& a, float& b) { const h2v t = __builtin_bit_cast(h2v, w); a = __expf((float)t[0] * 0.015625f); b = (float)t[1]; }
__device__ __forceinline__ void rope_cs(int pos, double inv, float& c, float& sn) { double rev = (double)pos * inv * 0.15915494309189535; rev -= floor(rev); const float rf = (float)rev; c = __builtin_amdgcn_cosf(rf); sn = __builtin_amdgcn_sinf(rf); }
__device__ __forceinline__ const float* rope_row(const float* ROPE, int pos, int f0) { const int idx = pos < SEQ ? pos : SEQ + (pos - PAST); return ROPE + ((size_t)idx * 24 + f0) * 2; }
__device__ __forceinline__ int row_pos(int row) { return row < MP ? (row & (SEQ - 1)) : PAST + ((row - MP) & 3); }
__device__ __forceinline__ int row_arow(int row) { return row < MP ? (row >> 11) : 16 + ((row - MP) >> 2); }

namespace pg {
constexpr int BM = 256, BK = 64, HALF = 128, HTB = HALF * BK * 2, STAGE_BYTES = 8 * HTB, NXCD = 8, WGM = 8;
__host__ __device__ __forceinline__ int lds_byte(int r, int c) { const int st = (r >> 4) * 2 + (c >> 5), rr = r & 15, cc = c & 31, ob = rr * 64 + cc * 2; return st * 1024 + (ob ^ (((ob >> 9) & 1) << 5)); }
__host__ __device__ __forceinline__ void stage_rc(int b, int& R, int& C) { const int st = b / 1024, sb = b % 1024, swz = sb ^ (((sb >> 9) & 1) << 5); R = (st >> 1) * 16 + swz / 64; C = (st & 1) * 32 + (swz % 64) / 2; }

__host__ __device__ __forceinline__ int perm32(int rho) { const int n = rho >> 4, i = rho & 15; return 8 * (i >> 2) + 4 * n + (i & 3); }
struct Unit { int pm, pn; long aoff, boff; };
struct Gemm { const f16* A; const f16* Bt; int lda, ldb, K; };

template <class MAP> struct GridOrder {
    int nM, nN, nwg, G, c; MAP map;
    __device__ void init(int nM_, int nN_, int G_, int c_, MAP m) { nM = nM_; nN = nN_; nwg = nM * nN; G = G_; c = c_; map = m; }
    __device__ bool next(int i, Unit& u) const {
        const long L = (long)i * G + c; if (L >= nwg) return false;
        int wgid = (int)L; { const int q = nwg / NXCD, r = nwg % NXCD, xcd = wgid % NXCD, off = wgid / NXCD; wgid = (xcd < r ? xcd * (q + 1) : r * (q + 1) + (xcd - r) * q) + off; }
        const int nig = WGM * nN, gid = wgid / nig, fm = gid * WGM, gsz = (nM - fm) < WGM ? (nM - fm) : WGM;
        u.pm = fm + ((wgid % nig) % gsz); u.pn = (wgid % nig) / gsz; map(u); return true;
    }
};

template <class Epi, class Sched>
__device__ __forceinline__ void gemm_phase(LAS unsigned char* lds, const Gemm g, const Sched& S, const Epi& E, const int wv_s) {
    const int tid = tid_fresh(), wid = __builtin_amdgcn_readfirstlane(tid >> 6), lane = tid & 63, wr = wid >> 2, wc = wid & 3, fr = lane & 15, fq = lane >> 4;
    const int K = g.K, nt = K / BK;
    unsigned voffA[2], voffB[2];
#pragma unroll
    for (int i = 0; i < 2; ++i) { int R, C; stage_rc(tid * 16 + i * 8192, R, C); const int Rb = (R & ~31) + perm32(R & 31);
        voffA[i] = (unsigned)(R * g.lda + C) * 2u; voffB[i] = (unsigned)(Rb * g.ldb + C) * 2u; }
    const size_t kstep = (size_t)(BK * 2);
    const size_t hstepA = (size_t)HALF * g.lda * 2, hstepB = (size_t)HALF * g.ldb * 2;
    const unsigned ldsw = (unsigned)wid * 1024u;
    const int aoff = lds_byte(wr * 64 + fr, fq * 8), boff = lds_byte(wc * 32 + fr, fq * 8);
#define PG_SA(b, h) (((b) * 2 + (h)) * HTB)
#define PG_SB(b, h) ((4 + (b) * 2 + (h)) * HTB)
#define PG_STAGE(bufoff, gbase, voff) do { _Pragma("unroll") for (int _i = 0; _i < 2; ++_i) \
        __builtin_amdgcn_global_load_lds((const unsigned*)((const char*)(gbase) + (voff)[_i]), (LAS unsigned*)(lds + (bufoff) + ldsw + _i * 8192), 16, 0, 0); } while (0)
#define PG_LDA(dst, b, h) do { _Pragma("unroll") for (int m = 0; m < 4; ++m) _Pragma("unroll") for (int k = 0; k < 2; ++k) dst[m][k] = *(const LAS h8*)(lds + PG_SA(b, h) + aoff + m * 2048 + k * 1024); } while (0)
#define PG_LDB(dst, b, h) do { _Pragma("unroll") for (int n = 0; n < 2; ++n) _Pragma("unroll") for (int k = 0; k < 2; ++k) dst[n][k] = *(const LAS h8*)(lds + PG_SB(b, h) + boff + n * 2048 + k * 1024); } while (0)
#define PG_MMA(ai, bj, At, Bt) do { __builtin_amdgcn_s_setprio(1); _Pragma("unroll") for (int m = 0; m < 4; ++m) _Pragma("unroll") for (int n = 0; n < 2; ++n) _Pragma("unroll") for (int k = 0; k < 2; ++k) \
        acc[ai][bj][m][n] = __builtin_amdgcn_mfma_f32_16x16x32_f16(Bt[n][k], At[m][k], acc[ai][bj][m][n], 0, 0, 0); __builtin_amdgcn_s_setprio(0); } while (0)
#define PG_WAIT_V(n) asm volatile("s_waitcnt vmcnt(" #n ")" ::: "memory")
#define PG_WAIT_L(n) asm volatile("s_waitcnt lgkmcnt(" #n ")" ::: "memory")
#define PG_BAR __builtin_amdgcn_s_barrier()
#define PG_SCHED __builtin_amdgcn_sched_barrier(0)
    Unit cur, nxt; int ui = 0;
    if (!S.next(0, cur)) return;
    f32x4 acc[2][2][4][2];
#pragma unroll
    for (int a = 0; a < 2; ++a)
#pragma unroll
        for (int b = 0; b < 2; ++b)
#pragma unroll
            for (int m = 0; m < 4; ++m)
#pragma unroll
                for (int n = 0; n < 2; ++n) acc[a][b][m][n] = (f32x4){0.f, 0.f, 0.f, 0.f};
    h8 At[4][2], B0[2][2], B1[2][2];
    const char* cA = (const char*)g.A + (size_t)cur.aoff * 2; const char* cB = (const char*)g.Bt + (size_t)cur.boff * 2;
    PG_STAGE(PG_SB(0, 0), cB, voffB); PG_STAGE(PG_SA(0, 0), cA, voffA); PG_STAGE(PG_SB(0, 1), cB + hstepB, voffB); PG_STAGE(PG_SA(0, 1), cA + hstepA, voffA);
    if (wr == 1) PG_BAR;
    PG_WAIT_V(4); PG_BAR;
    PG_STAGE(PG_SB(1, 0), cB + kstep, voffB); PG_STAGE(PG_SA(1, 0), cA + kstep, voffA); PG_STAGE(PG_SB(1, 1), cB + hstepB + kstep, voffB);
    PG_WAIT_V(6); PG_BAR;
    for (;;) {
        const bool has_next = S.next(ui + 1, nxt);
        const char* nA = has_next ? (const char*)g.A + (size_t)nxt.aoff * 2 : cA; const char* nB = has_next ? (const char*)g.Bt + (size_t)nxt.boff * 2 : cB;
#pragma nounroll
        for (int t = 0; t < nt; t += 2) {
            const bool last = (t == nt - 2);
            const char* a1 = cA + (size_t)(t + 1) * kstep;
            const char* a2 = last ? nA : cA + (size_t)(t + 2) * kstep; const char* b2 = last ? nB : cB + (size_t)(t + 2) * kstep;
            const char* a3 = a2 + kstep; const char* b3 = b2 + kstep;
            PG_LDB(B0, 0, 0); PG_SCHED; PG_LDA(At, 0, 0); PG_STAGE(PG_SA(1, 1), a1 + hstepA, voffA);
            PG_WAIT_L(8); PG_BAR; PG_WAIT_L(0); PG_MMA(0, 0, At, B0); PG_BAR; PG_SCHED;
            PG_LDB(B1, 0, 1); PG_STAGE(PG_SB(0, 0), b2, voffB);
            PG_BAR; PG_WAIT_L(0); PG_MMA(0, 1, At, B1); PG_BAR;
            PG_LDA(At, 0, 1); PG_STAGE(PG_SA(0, 0), a2, voffA);
            PG_BAR; PG_WAIT_L(0); PG_MMA(1, 0, At, B0); PG_BAR; PG_SCHED;
            PG_STAGE(PG_SB(0, 1), b2 + hstepB, voffB);
            PG_WAIT_V(6); PG_BAR; PG_MMA(1, 1, At, B1); PG_BAR;
            PG_LDB(B0, 1, 0); PG_SCHED; PG_LDA(At, 1, 0); PG_STAGE(PG_SA(0, 1), a2 + hstepA, voffA);
            PG_WAIT_L(8); PG_BAR; PG_WAIT_L(0); PG_MMA(0, 0, At, B0); PG_BAR; PG_SCHED;
            PG_LDB(B1, 1, 1); PG_STAGE(PG_SB(1, 0), b3, voffB);
            PG_BAR; PG_WAIT_L(0); PG_MMA(0, 1, At, B1); PG_BAR;
            PG_LDA(At, 1, 1); PG_STAGE(PG_SA(1, 0), a3, voffA);
            PG_BAR; PG_WAIT_L(0); PG_MMA(1, 0, At, B0); PG_BAR; PG_SCHED;
            PG_STAGE(PG_SB(1, 1), b3 + hstepB, voffB);
            PG_WAIT_V(6); PG_BAR; PG_MMA(1, 1, At, B1); PG_BAR;
        }
        E(acc, cur, wr, wc, fr, fq);
        if (!has_next) break;
#pragma unroll
        for (int a = 0; a < 2; ++a)
#pragma unroll
            for (int b = 0; b < 2; ++b)
#pragma unroll
                for (int m = 0; m < 4; ++m)
#pragma unroll
                    for (int n = 0; n < 2; ++n) acc[a][b][m][n] = (f32x4){0.f, 0.f, 0.f, 0.f};
        cur = nxt; cA = nA; cB = nB; ++ui;
    }
    PG_WAIT_V(0);
    if (wr == 0) PG_BAR;
    PG_BAR;
#undef PG_SA
#undef PG_SB
#undef PG_STAGE
#undef PG_LDA
#undef PG_LDB
#undef PG_MMA
#undef PG_WAIT_V
#undef PG_WAIT_L
#undef PG_BAR
#undef PG_SCHED
}
}

struct MapFull { int lda, ldb; __device__ void operator()(pg::Unit& u) const { u.aoff = (long)u.pm * 256 * lda; u.boff = (long)u.pn * 256 * ldb; } };
struct MapGates { __device__ void operator()(pg::Unit& u) const { u.aoff = (long)u.pm * 256 * D + (u.pn >> 1) * 256; u.boff = (long)u.pn * 256 * 256; } };

__device__ __forceinline__ size_t as16_off(int rs, int k) { return ((size_t)(((k >> 5) * 8 + (rs >> 4)) * 64 + ((k >> 3) & 3) * 16 + (rs & 15))) * 8 + (k & 7); }

__device__ __forceinline__ h8 to_h8(f32x4 a, f32x4 b) { h8 r; r[0] = (f16)a[0]; r[1] = (f16)a[1]; r[2] = (f16)a[2]; r[3] = (f16)a[3]; r[4] = (f16)b[0]; r[5] = (f16)b[1]; r[6] = (f16)b[2]; r[7] = (f16)b[3]; return r; }
__device__ __forceinline__ f32x4 silu4(f32x4 v) { f32x4 s; s[0] = silu_f(v[0]); s[1] = silu_f(v[1]); s[2] = silu_f(v[2]); s[3] = silu_f(v[3]); return s; }
template <class Emit> struct EpiMain {
    Emit em;
    __device__ __forceinline__ void operator()(const f32x4 (&acc)[2][2][4][2], const pg::Unit& u, int wr, int wc, int fr, int fq) const {
        const int pn = __builtin_amdgcn_readfirstlane(u.pn);
#pragma unroll
        for (int ai = 0; ai < 2; ++ai)
#pragma unroll
            for (int m = 0; m < 4; ++m) {
                const int row = u.pm * 256 + ai * 128 + wr * 64 + m * 16 + fr;
#pragma unroll
                for (int bj = 0; bj < 2; ++bj) em.template emit8<false>(pn, row, u.pn * 256 + bj * 128 + wc * 32 + 8 * fq, acc[ai][bj][m][0], acc[ai][bj][m][1]);
            }
    }
};

struct EmitNull { template <bool SMP> __device__ __forceinline__ void emit8(int pn, int row, int col, const f32x4 v, const f32x4 w) const { if (v[0] == 1.2345e30f && w[0] == 1.f) *(volatile int*)nullptr = row + col; } };
struct EmitInproj {
    f16 *Q, *QI, *SG, *VT; float* WI; float* out;
    template <bool SMP> __device__ __forceinline__ void emit(int pn, int row, int col, const f32x4 v) const {
        constexpr bool smp = SMP; const int rs = row - MP;
        if (pn < 4) { *(h4*)(Q + (size_t)row * D + col) = to_h4(v); }
        else if (pn == 4) { float* dst = smp ? out + O_KS + (size_t)rs * 256 + (col - 1024) : out + O_K + (size_t)row * 256 + (col - 1024); *(f32x4*)dst = v; }
        else if (pn == 5) {
            const int c5 = col - 1280;
            float* dst = smp ? out + O_VS + (size_t)rs * 256 + c5 : out + O_V + (size_t)row * 256 + c5; *(f32x4*)dst = v;
            if (!smp) { const int b = row >> 11, pos = row & (SEQ - 1), kvh = c5 >> 7, d = c5 & 127;
                const int pk = pos & 15, pp = (pos & ~15) | (pk < 4 ? pk : (pk < 8 ? pk + 4 : (pk < 12 ? pk - 4 : pk)));
                f16* vt = VT + ((size_t)(b * 2 + kvh) * 128 + d) * SEQ + pp;
                vt[0] = (f16)v[0]; vt[SEQ] = (f16)v[1]; vt[2 * SEQ] = (f16)v[2]; vt[3 * SEQ] = (f16)v[3]; }
        }
        else if (pn < 10) { *(h4*)(QI + (size_t)row * D + (col - 1536)) = to_h4(v); }
        else if (pn < 14) { *(h4*)(SG + (size_t)row * D + (col - 2560)) = to_h4(v); }
        else { const int c14 = col - 3584;
            if (c14 < 64) { float* dst = smp ? out + O_IKS + (size_t)rs * 64 + c14 : out + O_IK + (size_t)row * 64 + c14; *(f32x4*)dst = v; }
            else if (c14 < 80) { *(f32x4*)(WI + (size_t)row * 16 + (c14 - 64)) = v * 0.03125f; } }
    }
    template <bool SMP> __device__ __forceinline__ void emit8(int pn, int row, int col, const f32x4 v, const f32x4 w) const {
        if (pn < 4) { *(h8*)(Q + (size_t)row * D + col) = to_h8(v, w); }
        else if (pn >= 6 && pn < 10) { *(h8*)(QI + (size_t)row * D + (col - 1536)) = to_h8(v, w); }
        else if (pn >= 10 && pn < 14) { *(h8*)(SG + (size_t)row * D + (col - 2560)) = to_h8(v, w); }
        else { emit<SMP>(pn, row, col, v); emit<SMP>(pn, row, col + 4, w); }
    }
};

struct EmitResid {
    const float *xa, *xb; const float* gate; float *oa, *ob;
    template <bool SMP> __device__ __forceinline__ void emit(int pn, int row, int col, const f32x4 v) const {
        constexpr bool smp = SMP; const int rs = row - MP;
        const f32x4 gv = *(const f32x4*)(gate + (size_t)row_arow(row) * 3072 + 2048 + col);
        const f32x4 xv = smp ? *(const f32x4*)(xb + (size_t)rs * D + col) : *(const f32x4*)(xa + (size_t)row * D + col);
        float* dst = smp ? ob + (size_t)rs * D + col : oa + (size_t)row * D + col;
        *(f32x4*)dst = xv + gv * v;
    }
    template <bool SMP> __device__ __forceinline__ void emit8(int pn, int row, int col, const f32x4 v, const f32x4 w) const { emit<SMP>(pn, row, col, v); emit<SMP>(pn, row, col + 4, w); }
};

struct EpiResidH {
    const float* x; const float *ada0, *ada1, *ng1; float* X1; f16* Hn; float* SSP;
    __device__ __forceinline__ void operator()(const f32x4 (&acc)[2][2][4][2], const pg::Unit& u, int wr, int wc, int fr, int fq) const {
        const int pn = __builtin_amdgcn_readfirstlane(u.pn), pm = __builtin_amdgcn_readfirstlane(u.pm);
        const float *a0 = ada0 + (size_t)(pm >> 3) * 3072 + 2048, *a1 = ada1 + (size_t)(pm >> 3) * 3072 + 1024;
        f32x4 gt[2][2], ff[2][2];
#pragma unroll
        for (int bj = 0; bj < 2; ++bj)
#pragma unroll
            for (int n = 0; n < 2; ++n) { const int c = pn * 256 + bj * 128 + wc * 32 + 8 * fq + 4 * n;
                gt[bj][n] = *(const f32x4*)(a0 + c); ff[bj][n] = *(const f32x4*)(ng1 + c) * (*(const f32x4*)(a1 + c) + 1.f); }
#pragma unroll
        for (int ai = 0; ai < 2; ++ai)
#pragma unroll
            for (int m = 0; m < 4; ++m) {
                const int row = pm * 256 + ai * 128 + wr * 64 + m * 16 + fr;
                float ss = 0.f;
#pragma unroll
                for (int bj = 0; bj < 2; ++bj) { const int c = pn * 256 + bj * 128 + wc * 32 + 8 * fq;
                    const float* xr = x + (size_t)row * D + c;
                    const f32x4 y0 = *(const f32x4*)xr + gt[bj][0] * acc[ai][bj][m][0], y1 = *(const f32x4*)(xr + 4) + gt[bj][1] * acc[ai][bj][m][1];
                    float* d = X1 + (size_t)row * D + c; *(f32x4*)d = y0; *(f32x4*)(d + 4) = y1;
                    *(h8*)(Hn + (size_t)row * D + c) = to_h8(y0 * ff[bj][0], y1 * ff[bj][1]);
                    ss += y0[0] * y0[0] + y0[1] * y0[1] + y0[2] * y0[2] + y0[3] * y0[3] + y1[0] * y1[0] + y1[1] * y1[1] + y1[2] * y1[2] + y1[3] * y1[3]; }
                ss += __shfl_xor(ss, 16); ss += __shfl_xor(ss, 32);
                if (fq == 0) SSP[(size_t)row * 16 + pn * 4 + wc] = ss;
            }
    }
};
struct EmitResidHS {
    const float* xs; const float *ada0, *ada1, *ng1; float* X1s; f16* HS; float* SSPS;
    template <bool SMP> __device__ __forceinline__ void emit(int pn, int row, int col, const f32x4 v) const {
        const int rs = row - MP, ar = 16 + (rs >> 2);
        const f32x4 y = *(const f32x4*)(xs + (size_t)rs * D + col) + *(const f32x4*)(ada0 + (size_t)ar * 3072 + 2048 + col) * v;
        *(f32x4*)(X1s + (size_t)rs * D + col) = y;
        const f32x4 f = *(const f32x4*)(ng1 + col) * (*(const f32x4*)(ada1 + (size_t)ar * 3072 + 1024 + col) + 1.f);
        *(h4*)(HS + as16_off(rs, col)) = to_h4(y * f);
        float ss = y[0] * y[0] + y[1] * y[1] + y[2] * y[2] + y[3] * y[3];
        ss += __shfl_xor(ss, 16); ss += __shfl_xor(ss, 32);
        if ((col & 15) == 0) SSPS[(size_t)rs * 64 + (col >> 4)] = ss;
    }
};
struct EmitSW {
    float* SW;
    template <bool SMP> __device__ __forceinline__ void emit(int pn, int row, int col, const f32x4 v) const { const int rs = row - MP; if (rs < 48) *(f32x4*)(SW + (size_t)rs * 2 * D + col) = v; }
};

struct EmitLruIn {
    f16* XB; f16* G1; const float *SSPS, *SW;
    template <bool SMP> __device__ __forceinline__ void emit(int pn, int row, int col, const f32x4 v0) const {
        const int rs = row - MP;
        f32x4 t = (f32x4){0.f, 0.f, 0.f, 0.f};
#pragma unroll
        for (int i = 0; i < 16; ++i) t += *(const f32x4*)(SSPS + (size_t)rs * 64 + 4 * i);
        const float rstd = rsqrtf(((t[0] + t[1]) + (t[2] + t[3])) * (1.f / D) + EPS);
        const f32x4 v = v0 * rstd + *(const f32x4*)(SW + (size_t)(16 + (rs >> 2)) * 2 * D + col);
        if (pn < 4) { *(h4*)(XB + (size_t)row * D + col) = to_h4(v); }
        else { *(h4*)(G1 + (size_t)row * D + (col - 1024)) = to_h4(silu4(v)); }
    }
    template <bool SMP> __device__ __forceinline__ void emit8(int pn, int row, int col, const f32x4 v, const f32x4 w) const {
        if (pn < 4) { *(h8*)(XB + (size_t)row * D + col) = to_h8(v, w); }
        else { *(h8*)(G1 + (size_t)row * D + (col - 1024)) = to_h8(silu4(v), silu4(w)); }
    }
};

#define DPP_ROW_ROR(n) (0x120 + (n))
#define dpp_ror_f(src, n) __int_as_float(__builtin_amdgcn_update_dpp(__float_as_int(src), __float_as_int(src), DPP_ROW_ROR(n), 0xf, 0xf, false))
struct EpiLruIn {
    EmitLruIn em; f16* XC; float* XCH; float* XBT; float* out; const float *cw, *cb; LAS unsigned char* lds; const float *SSP, *SW;
    __device__ __forceinline__ void operator()(f32x4 (&acc)[2][2][4][2], const pg::Unit& u, int wr, int wc, int fr, int fq) const {
        const int pn = __builtin_amdgcn_readfirstlane(u.pn), pm = __builtin_amdgcn_readfirstlane(u.pm);
        {
            f32x4 sw[2][2];
#pragma unroll
            for (int bj = 0; bj < 2; ++bj)
#pragma unroll
                for (int n = 0; n < 2; ++n) sw[bj][n] = *(const f32x4*)(SW + (size_t)(pm >> 3) * 2 * D + pn * 256 + bj * 128 + wc * 32 + 8 * fq + 4 * n);
#pragma unroll
            for (int ai = 0; ai < 2; ++ai)
#pragma unroll
                for (int m = 0; m < 4; ++m) {
                    const float* sp = SSP + (size_t)(pm * 256 + ai * 128 + wr * 64 + m * 16 + fr) * 16;
                    const f32x4 t = (*(const f32x4*)sp + *(const f32x4*)(sp + 4)) + (*(const f32x4*)(sp + 8) + *(const f32x4*)(sp + 12));
                    const float rstd = rsqrtf(((t[0] + t[1]) + (t[2] + t[3])) * (1.f / D) + EPS);
#pragma unroll
                    for (int bj = 0; bj < 2; ++bj)
#pragma unroll
                        for (int n = 0; n < 2; ++n) acc[ai][bj][m][n] = acc[ai][bj][m][n] * rstd + sw[bj][n];
                }
        }
        if (pn >= 4) {
#pragma unroll
            for (int ai = 0; ai < 2; ++ai)
#pragma unroll
                for (int m = 0; m < 4; ++m) {
                    const int row = pm * 256 + ai * 128 + wr * 64 + m * 16 + fr;
#pragma unroll
                    for (int bj = 0; bj < 2; ++bj) em.template emit8<false>(pn, row, pn * 256 + bj * 128 + wc * 32 + 8 * fq, acc[ai][bj][m][0], acc[ai][bj][m][1]);
                }
            return;
        }
        LAS float* T = (LAS float*)(lds + LDS_AUX);
        const int lc = wc * 32 + 8 * fq;
        if (fr >= 13) {
#pragma unroll
            for (int ai = 0; ai < 2; ++ai)
#pragma unroll
                for (int bj = 0; bj < 2; ++bj)
#pragma unroll
                    for (int n = 0; n < 2; ++n) *(LAS f32x4*)(T + ((2 * ai + wr) * 3 + (fr - 13)) * 256 + 128 * bj + lc + 4 * n) = acc[ai][bj][3][n];
        }
        asm volatile("s_waitcnt lgkmcnt(0)" ::: "memory");
        __builtin_amdgcn_s_barrier(); __builtin_amdgcn_s_barrier();
        asm volatile("" ::: "memory");
#pragma unroll
        for (int bj = 0; bj < 2; ++bj)
#pragma unroll
        for (int n = 0; n < 2; ++n) {
            const int gc = pn * 256 + 128 * bj + lc + 4 * n, tc = 128 * bj + lc + 4 * n;
            const f32x4 w0 = *(const f32x4*)(cw + gc), w1 = *(const f32x4*)(cw + D + gc), w2 = *(const f32x4*)(cw + 2 * D + gc), w3 = *(const f32x4*)(cw + 3 * D + gc), bs = *(const f32x4*)(cb + gc);
#pragma unroll
            for (int ai = 0; ai < 2; ++ai) {
                const int slab = 2 * ai + wr;
                f32x4 prev = (f32x4){0.f, 0.f, 0.f, 0.f};
                if (slab > 0 && fr >= 13) prev = *(const LAS f32x4*)(T + ((slab - 1) * 3 + (fr - 13)) * 256 + tc);
#pragma unroll
                for (int m = 0; m < 4; ++m) {
                    const f32x4 xv = acc[ai][bj][m][n];
                    f32x4 y;
#pragma unroll
                    for (int e = 0; e < 4; ++e) {
                        const float X = xv[e], P = prev[e];
                        const float s1 = fr >= 15 ? P : X, s2 = fr >= 14 ? P : X, s3 = fr >= 13 ? P : X;
                        y[e] = bs[e] + w3[e] * X + w2[e] * dpp_ror_f(s1, 1) + w1[e] * dpp_ror_f(s2, 2) + w0[e] * dpp_ror_f(s3, 3);
                    }
                    const int row = pm * 256 + ai * 128 + wr * 64 + m * 16 + fr;
                    *(h4*)(XC + (size_t)row * D + gc) = to_h4(y);
                    if (slab == 0 && m == 0 && fr < 3) *(f32x4*)(XCH + ((size_t)pm * 3 + fr) * D + gc) = y;
                    if (slab == 3 && m == 3 && fr >= 13) {
                        *(f32x4*)(XBT + ((size_t)pm * 3 + (fr - 13)) * D + gc) = xv;
                        if ((pm & 7) == 7) *(f32x4*)(out + O_CP + ((size_t)(pm >> 3) * 3 + (fr - 13)) * D + gc) = xv;
                    }
                    prev = xv;
                }
            }
        }
    }
};

struct GateCols { f32x4 ba, bx, ls; };
struct EmitGates {
    const f16* XC; const float *b_a, *b_x, *lam; unsigned* LB;
    __device__ __forceinline__ GateCols cols(int ch) const {
        GateCols g; g.ba = *(const f32x4*)(b_a + ch) * -1.44269504f; g.bx = *(const f32x4*)(b_x + ch) * -1.44269504f; g.ls = *(const f32x4*)(lam + ch);
        return g; }
    __device__ __forceinline__ unsigned elem(float rp, float ip, float ba, float bx, float ls, float xc) const {
        const float er = __builtin_amdgcn_exp2f(__builtin_fmaf(rp, -1.44269504f, ba)), ei = __builtin_amdgcn_exp2f(__builtin_fmaf(ip, -1.44269504f, bx));
        const float l = ls * __builtin_amdgcn_rcpf(1.f + er);
        const float x2 = 2.f * l;
        const float ser = -x2 * (1.f + x2 * (0.5f + x2 * 0.16666667f));
        const float dir = 1.f - __builtin_amdgcn_exp2f(2.88539008f * l);
        const float om0 = (x2 > -0.03125f) ? ser : dir;
        const int ob = __builtin_bit_cast(int, om0), fl = __builtin_bit_cast(int, 1e-30f);
        const float om = __builtin_bit_cast(float, ob > fl ? ob : fl);
        const float t = 1.f + ei;
        return pack_lb(l, om * __builtin_amdgcn_rsqf(om * t * t) * xc);
    }
    __device__ __forceinline__ void emit2(int row, int ch, const GateCols& g, const f32x4 rp, const f32x4 ip) const {
        const h4 xc = *(const h4*)(XC + (size_t)row * D + ch);
        u32x4 lb;
#pragma unroll
        for (int e = 0; e < 4; ++e) lb[e] = elem(rp[e], ip[e], g.ba[e], g.bx[e], g.ls[e], (float)xc[e]);
        *(u32x4*)(LB + (size_t)row * D + ch) = lb;
    }
    __device__ __forceinline__ void emit8g(int row, int ch, const GateCols& g0, const GateCols& g1, const f32x4 rp0, const f32x4 ip0, const f32x4 rp1, const f32x4 ip1) const {
        const h8 xc = *(const h8*)(XC + (size_t)row * D + ch);
        u32x4 lb0, lb1;
#pragma unroll
        for (int e = 0; e < 4; ++e) { lb0[e] = elem(rp0[e], ip0[e], g0.ba[e], g0.bx[e], g0.ls[e], (float)xc[e]); lb1[e] = elem(rp1[e], ip1[e], g1.ba[e], g1.bx[e], g1.ls[e], (float)xc[4 + e]); }
        unsigned* dst = LB + (size_t)row * D + ch;
        *(u32x4*)dst = lb0; *(u32x4*)(dst + 4) = lb1;
    }
};
struct EpiGates {
    EmitGates em;
    __device__ __forceinline__ void operator()(const f32x4 (&acc)[2][2][4][2], const pg::Unit& u, int wr, int wc, int fr, int fq) const {
        const int chb = (u.pn >> 1) * 256 + (u.pn & 1) * 128 + wc * 32 + 8 * fq;
        const GateCols g0 = em.cols(chb), g1 = em.cols(chb + 4);
#pragma unroll
        for (int ai = 0; ai < 2; ++ai)
#pragma unroll
            for (int m = 0; m < 4; ++m) em.emit8g(u.pm * 256 + ai * 128 + wr * 64 + m * 16 + fr, chb, g0, g1, acc[ai][0][m][0], acc[ai][1][m][0], acc[ai][0][m][1], acc[ai][1][m][1]);
    }
};

template <int NCH, int SPW> __device__ __forceinline__ void thin_unit(const f16* AS, const f16* w0, const f16* w1, int s0, f32x4 (&acc)[NCH][8], int lane) {
    const int fq = lane >> 4;
    const f16* ap = AS + ((size_t)s0 * 8 * 64 + lane) * 8;
    h8 wq[SPW][NCH], aq[SPW][8];
#pragma unroll
    for (int s = 0; s < SPW; ++s) {
        wq[s][0] = *(const h8*)(w0 + s * 32 + 8 * fq); if (NCH == 2) wq[s][NCH - 1] = *(const h8*)(w1 + s * 32 + 8 * fq);
#pragma unroll
        for (int rb = 0; rb < 8; ++rb) aq[s][rb] = *(const h8*)(ap + ((size_t)s * 8 + rb) * 512);
    }
#pragma unroll
    for (int c = 0; c < NCH; ++c)
#pragma unroll
        for (int rb = 0; rb < 8; ++rb) acc[c][rb] = (f32x4){0.f, 0.f, 0.f, 0.f};
#pragma unroll
    for (int s = 0; s < SPW; ++s)
#pragma unroll
        for (int c = 0; c < NCH; ++c)
#pragma unroll
            for (int rb = 0; rb < 8; ++rb) acc[c][rb] = __builtin_amdgcn_mfma_f32_16x16x32_f16(wq[s][c], aq[s][rb], acc[c][rb], 0, 0, 0);
}
template <int NCH> __device__ __forceinline__ void thin_reduce(LAS unsigned char* lds, const f32x4 (&acc)[NCH][8], f32x4 (&tot)[NCH], int wave, int lane) {
    LAS f32x4* red = (LAS f32x4*)lds;
    __syncthreads();
#pragma unroll
    for (int c = 0; c < NCH; ++c)
#pragma unroll
        for (int rb = 0; rb < 8; ++rb) red[(wave * (NCH * 8) + c * 8 + rb) * 64 + lane] = acc[c][rb];
    __syncthreads();
#pragma unroll
    for (int c = 0; c < NCH; ++c) { f32x4 t = red[(c * 8 + wave) * 64 + lane];
#pragma unroll
        for (int w = 1; w < 8; ++w) t += red[(w * (NCH * 8) + c * 8 + wave) * 64 + lane];
        tot[c] = t; }
    __syncthreads();
}

template <class Emit> __device__ __forceinline__ void thin_gemm(LAS unsigned char* lds, const f16* AS, const f16* Bt, int ldb, int ncols, const Emit& em, const int wv_s, const int wg_lo = 0, const int wg_n = 1 << 30) {
    const int tid_ = tid_fresh(), lane = tid_ & 63, wave = tid_ >> 6, fr = lane & 15, fq = lane >> 4;
    const int nwg = wg_n < (int)gridDim.x - wg_lo ? wg_n : (int)gridDim.x - wg_lo;
    if ((int)blockIdx.x < wg_lo || (int)blockIdx.x >= wg_lo + nwg) return;
    for (int u = (int)blockIdx.x - wg_lo; u < ncols / 16; u += nwg) {
        const int n0 = u * 16;
        f32x4 acc[1][8], tot[1];
        thin_unit<1, 4>(AS, Bt + (size_t)(n0 + fr) * ldb + wave * 128, nullptr, wave * 4, acc, lane);
        thin_reduce<1>(lds, acc, tot, wave, lane);
        em.template emit<true>(__builtin_amdgcn_readfirstlane(n0 >> 8), MP + wave * 16 + fr, n0 + 4 * fq, tot[0]);
    }
}
__device__ __forceinline__ void thin_gemm_gates(LAS unsigned char* lds, const f16* AS, const f16* Wg, const EmitGates& em, const int wv_s) {
    const int tid_ = tid_fresh(), lane = tid_ & 63, wave = tid_ >> 6, fr = lane & 15, fq = lane >> 4;
    for (int u = (int)blockIdx.x; u < 64; u += (int)gridDim.x) {
        const int pn = u >> 3, g16 = u & 7;
        const int ch = (pn >> 1) * 256 + (pn & 1) * 128 + g16 * 16 + 4 * fq;
        f32x4 acc[2][8], tot[2];
        thin_unit<2, 1>(AS, Wg + (size_t)(pn * 256 + g16 * 16 + fr) * 256 + wave * 32, Wg + (size_t)(pn * 256 + 128 + g16 * 16 + fr) * 256 + wave * 32, (pn >> 1) * 8 + wave, acc, lane);
        thin_reduce<2>(lds, acc, tot, wave, lane);
        const GateCols g = em.cols(ch);
        em.emit2(MP + wave * 16 + fr, ch, g, tot[0], tot[1]);
    }
}

template <class F, class R> __device__ __forceinline__ void conv_weight(f16* dst, int nrows, int K, F src_at, R dst_row, long gtid_, long gthreads_) {
    const unsigned kc = (unsigned)K / 8u, total = (unsigned)nrows * kc, gtid = (unsigned)gtid_, gthreads = (unsigned)gthreads_;
    for (unsigned ch = gtid; ch < total; ch += 2u * gthreads) {
        const unsigned ch2 = ch + gthreads; const bool two = ch2 < total;
        const int k0 = (int)(ch / (unsigned)nrows) * 8, n = (int)(ch - (unsigned)(k0 / 8) * (unsigned)nrows);
        const int k02 = two ? (int)(ch2 / (unsigned)nrows) * 8 : k0, n2 = two ? (int)(ch2 - (unsigned)(k02 / 8) * (unsigned)nrows) : n;
        float a[8], c[8];
#pragma unroll
        for (int j = 0; j < 8; ++j) { a[j] = src_at(k0 + j, n); c[j] = src_at(k02 + j, n2); }
        h8 v, v2;
#pragma unroll
        for (int j = 0; j < 8; ++j) { v[j] = (f16)a[j]; v2[j] = (f16)c[j]; }
        *(h8*)(dst + (size_t)dst_row(n) * K + k0) = v;
        if (two) *(h8*)(dst + (size_t)dst_row(n2) * K + k02) = v2;
    }
}

constexpr int CT_WIN = NIN * 16, CT_WO0 = CT_WIN + D * 16, CT_WLIN = CT_WO0 + 2 * D * 16, CT_WLO = CT_WLIN + D * 16, CT_WA = CT_WLO + 1024 * 4, CT_WX = CT_WA + 1024 * 4, CT_TRIPS = CT_WX / 512;
static_assert(CT_WIN % 512 == 0 && CT_WX % 512 == 0, "trip granularity");
__device__ __forceinline__ void conv_trip(CParams& p, const int trip, const int tid) {
    const int it0 = __builtin_amdgcn_readfirstlane(trip * 512);
    const unsigned it = (unsigned)(it0 + tid);
    const float* base; unsigned off0, stride; f16* dst; bool valid = true;
    if (it0 < CT_WIN) {
        const unsigned kc = it / (unsigned)NIN; const int n = (int)(it - kc * (unsigned)NIN);
        int c; if (n < 2560) c = n; else if (n < 3584) c = n - 2560 + 2640; else if (n < 3648) c = n - 3584 + 2560; else if (n < 3664) c = n - 3648 + 2624; else c = -1;
        valid = c >= 0; base = p.w_in; off0 = kc * 64u * 3664u + (unsigned)(valid ? c : 0); stride = 3664u; dst = (f16*)(p.ws + WS_WIN) + (size_t)n * D + kc * 64;
    } else if (it0 < CT_WO0) { const unsigned l = it - CT_WIN, kc = l >> 10, n = l & 1023u;
        base = p.w_out0; off0 = kc * 64u * D + n; stride = D; dst = (f16*)(p.ws + WS_WO0) + (size_t)n * D + kc * 64;
    } else if (it0 < CT_WLIN) { const unsigned l = it - CT_WO0, kc = l >> 11, n = l & 2047u;
        base = p.lw_in; off0 = kc * 64u * 2u * D + n; stride = 2 * D; dst = (f16*)(p.ws + WS_WLIN) + (size_t)n * D + kc * 64;
    } else if (it0 < CT_WLO) { const unsigned l = it - CT_WLIN, kc = l >> 10, n = l & 1023u;
        base = p.lw_out; off0 = kc * 64u * D + n; stride = D; dst = (f16*)(p.ws + WS_WLO) + (size_t)n * D + kc * 64;
    } else {
        const bool isx = it0 >= CT_WA; const unsigned l = it - (isx ? CT_WA : CT_WLO), kc = l >> 10, n = l & 1023u;
        base = isx ? p.w_x : p.w_a;
        off0 = ((n >> 8) * 256u + kc * 64u) * 256u + (n & 255u); stride = 256u; dst = (f16*)(p.ws + WS_WG) + (size_t)((n >> 7) * 256u + (isx ? 128u : 0u) + (n & 127u)) * 256 + kc * 64;
    }
    float a[64];
#pragma unroll
    for (int j = 0; j < 64; ++j) a[j] = base[off0 + (unsigned)j * stride];
#pragma unroll
    for (int q = 0; q < 8; ++q) { h8 v;
#pragma unroll
        for (int e = 0; e < 8; ++e) v[e] = valid ? (f16)a[q * 8 + e] : (f16)0.f;
        *(h8*)(dst + q * 8) = v; }
}

__device__ __forceinline__ void ph0_prologue(CParams& p, LAS unsigned char* lds, const int wv_s) {
    const int tid = tid_fresh();
    const long gtid = (long)blockIdx.x * NTHR + tid, gth = (long)gridDim.x * NTHR;
    float* ADA = (float*)(p.ws + WS_ADA);
    LAS float* sc = (LAS float*)lds;
    LAS float* red = (LAS float*)(lds + 98304);
    const int cl = tid & 31, ks = tid >> 5;
    for (int item = blockIdx.x; item < 192; item += gridDim.x) {
        const int l = item / 96, cg = item % 96, col = cg * 32 + cl;
        const float* aw = p.ada_w + (size_t)l * D * 3072 + (size_t)ks * 64 * 3072 + col;
        float w[64];
#pragma unroll
        for (int i = 0; i < 64; ++i) w[i] = aw[(size_t)i * 3072];
        for (int half = 0; half < 2; ++half) {
            __syncthreads();
            for (int e = tid; e < 24 * 1024; e += NTHR) { const int r = 24 * half + (e >> 10), k = e & 1023; const float c = r < 16 ? p.c_p[r * D + k] : p.c_s[(r - 16) * D + k]; sc[e] = c * __builtin_amdgcn_rcpf(1.f + __expf(-c)); }
            __syncthreads();
            f32x2 acc[24];
            const LAS float *sc_lo = sc + ks * 64, *sc_hi = sc + 12 * 1024 + ks * 64; asm volatile("" : "+v"(sc_lo), "+v"(sc_hi));
#pragma unroll
            for (int r = 0; r < 24; ++r) acc[r] = (f32x2){0.f, 0.f};
#pragma unroll
            for (int k4 = 0; k4 < 16; ++k4) {
                const f32x2 wa = {w[4 * k4], w[4 * k4 + 1]}, wb = {w[4 * k4 + 2], w[4 * k4 + 3]};
#pragma unroll
                for (int rh = 0; rh < 2; ++rh) {
#pragma unroll
                    for (int r = 12 * rh; r < 12 * rh + 12; ++r) { const f32x4 s4 = *(const LAS f32x4*)((r < 12 ? sc_lo : sc_hi) + (r % 12) * 1024 + 4 * k4);
                        acc[r] = __builtin_elementwise_fma((f32x2){s4[0], s4[1]}, wa, acc[r]); acc[r] = __builtin_elementwise_fma((f32x2){s4[2], s4[3]}, wb, acc[r]); }
                    __builtin_amdgcn_sched_barrier(0);
                }
            }
#pragma unroll
            for (int r = 0; r < 24; ++r) red[(ks * 24 + r) * 32 + cl] = acc[r][0] + acc[r][1];
            __syncthreads();
            for (int e = tid; e < 768; e += NTHR) { const int r = e >> 5, c2 = e & 31; float s = 0.f;
                for (int q = 0; q < 16; ++q) s += red[(q * 24 + r) * 32 + c2];
                const int cc = cg * 32 + c2; ADA[((size_t)l * 48 + 24 * half + r) * 3072 + cc] = s + p.ada_b[l * 3072 + cc]; }
        }
    }
    __syncthreads();
    { float* LS = (float*)(p.ws + WS_LS); for (long i = gtid; i < D; i += gth) LS[i] = -8.f * log1pf(expf(-p.lam[i])); }
    { float* ROPE = (float*)(p.ws + WS_ROPE);
      for (long i = gtid; i < (long)(SEQ + DT) * 24; i += gth) { const int idx = (int)(i / 24), f = (int)(i % 24); const int pos = idx < SEQ ? idx : PAST + (idx - SEQ);
          float c, sn; rope_cs(pos, f < 16 ? INV32[f] : INV16[f - 16], c, sn); ROPE[i * 2] = c; ROPE[i * 2 + 1] = sn; } }
    {
        const int G = (int)gridDim.x, nada = G < 192 ? G : 192;
        const int w2 = ((int)blockIdx.x + G - nada) % G;
        for (int t = w2; t < CT_TRIPS; t += G) conv_trip(p, t, tid);
    }
}

__device__ __forceinline__ void ph_modulate(const float* xa, const float* xb, const float* ng, const float* ada, f16* H, f16* HS, const int wv_s) {
    const int tid_ = tid_fresh(), lane = tid_ & 63, gw = blockIdx.x * 8 + (tid_ >> 6), nw = gridDim.x * 8;
    for (int row = gw; row < MPAD; row += nw) {
        f16* hr = H + (size_t)row * D;
        if (row >= MT) {
#pragma unroll
            for (int i = 0; i < 4; ++i) *(h4*)(hr + (i * 64 + lane) * 4) = (h4){(f16)0.f, (f16)0.f, (f16)0.f, (f16)0.f};
            continue; }
        const float* src = row < MP ? xa + (size_t)row * D : xb + (size_t)(row - MP) * D;
        const float* ar = ada + (size_t)row_arow(row) * 3072;
        f32x4 xv[4]; float ss = 0.f;
#pragma unroll
        for (int i = 0; i < 4; ++i) { xv[i] = *(const f32x4*)(src + (i * 64 + lane) * 4); ss += xv[i][0] * xv[i][0] + xv[i][1] * xv[i][1] + xv[i][2] * xv[i][2] + xv[i][3] * xv[i][3]; }
        ss = wave_sum(ss);
        const float rs = rsqrtf(ss * (1.f / D) + EPS);
#pragma unroll
        for (int i = 0; i < 4; ++i) { const int c = (i * 64 + lane) * 4;
            const f32x4 g = *(const f32x4*)(ng + c), sh = *(const f32x4*)(ar + c), scv = *(const f32x4*)(ar + 1024 + c);
            f32x4 y;
#pragma unroll
            for (int e = 0; e < 4; ++e) y[e] = (xv[i][e] * rs * g[e]) * (1.f + scv[e]) + sh[e];
            if (row < MP) *(h4*)(hr + c) = to_h4(y); else *(h4*)(HS + as16_off(row - MP, c)) = to_h4(y); }
    }
}

__device__ __forceinline__ void ph3_fixup(CParams& p, const int wv_s) {
    const int tid_ = tid_fresh(), lane = tid_ & 63, gw = blockIdx.x * 8 + (tid_ >> 6), nw = gridDim.x * 8;
    f16* KH = (f16*)(p.ws + WS_KH); f16* KIH = (f16*)(p.ws + WS_KIH); const float* ROPE = (const float*)(p.ws + WS_ROPE);
    const int l5 = lane & 31, ri = lane >> 4, l4 = lane & 15;
    const f32x4 kn = *(const f32x4*)(p.k_norm + l5 * 4), qn4 = *(const f32x4*)(p.q_norm + l5 * 4);
    for (int row0 = gw * 4; row0 < MT; row0 += nw * 4) {
        float* kp[4]; f32x4 v[4], kc0[4], kc1[4];
#pragma unroll
        for (int i = 0; i < 4; ++i) { const int row = row0 + i;
            kp[i] = (row >= MP ? p.out + O_KS + (size_t)(row - MP) * 256 : p.out + O_K + (size_t)row * 256) + lane * 4;
            v[i] = *(const f32x4*)kp[i];
            const float* rr = rope_row(ROPE, row_pos(row), (l5 & 3) * 4); kc0[i] = *(const f32x4*)rr; kc1[i] = *(const f32x4*)(rr + 4); }
        const int rowi = row0 + ri;
        float* kip = (rowi >= MP ? p.out + O_IKS + (size_t)(rowi - MP) * 64 : p.out + O_IK + (size_t)rowi * 64) + l4 * 4;
        f32x4 w = *(const f32x4*)kip;
        const float* rri = rope_row(ROPE, row_pos(rowi), 16 + (l4 & 1) * 4); const f32x4 ic0 = *(const f32x4*)rri, ic1 = *(const f32x4*)(rri + 4);
#pragma unroll
        for (int i = 0; i < 4; ++i) { const int row = row0 + i;
            float ss = v[i][0] * v[i][0] + v[i][1] * v[i][1] + v[i][2] * v[i][2] + v[i][3] * v[i][3];
            ss += __shfl_xor(ss, 1); ss += __shfl_xor(ss, 2); ss += __shfl_xor(ss, 4); ss += __shfl_xor(ss, 8); ss += __shfl_xor(ss, 16);
            const float rn = rsqrtf(ss * (1.f / 128.f) + EPS);
            f32x4 x = v[i] * rn * kn;
            const float cs4[4] = {kc0[i][0], kc0[i][2], kc1[i][0], kc1[i][2]}, sn4[4] = {kc0[i][1], kc0[i][3], kc1[i][1], kc1[i][3]};
#pragma unroll
            for (int e = 0; e < 4; ++e) { const float o = __shfl_xor(x[e], 4); if (l5 < 4) x[e] = x[e] * cs4[e] - o * sn4[e]; else if (l5 < 8) x[e] = x[e] * cs4[e] + o * sn4[e]; }
            *(f32x4*)kp[i] = x;
            if (l5 >= 8) x = x * qn4;
            *(h4*)(KH + (size_t)row * 256 + lane * 4) = to_h4(x);
        }
        {
            const float cs4[4] = {ic0[0], ic0[2], ic1[0], ic1[2]}, sn4[4] = {ic0[1], ic0[3], ic1[1], ic1[3]};
#pragma unroll
            for (int e = 0; e < 4; ++e) { const float o = __shfl_xor(w[e], 2); if (l4 < 2) w[e] = w[e] * cs4[e] - o * sn4[e]; else if (l4 < 4) w[e] = w[e] * cs4[e] + o * sn4[e]; }
            *(f32x4*)kip = w;
            const int d4 = l4 * 4;
            if (rowi >= MP) *(h4*)(KIH + (size_t)rowi * 64 + d4) = to_h4(w);
            else { const int b_ = rowi >> 11, ps = rowi & (SEQ - 1);
                *(h4*)(KIH + ((((size_t)(b_ * 64 + (ps >> 5)) * 4 + (d4 >> 4)) * 2 + ((d4 >> 3) & 1)) * 32 + (ps & 31)) * 8 + (d4 & 7)) = to_h4(w); }
        }
    }
}

#define DPP_ROW_SHR(n) (0x110 + (n))
#define DPP_ROW_BCAST15 0x142
#define DPP_ROW_BCAST31 0x143
#define dpp_f(old, src, ctrl, row_mask, bc) __int_as_float(__builtin_amdgcn_update_dpp(__float_as_int(old), __float_as_int(src), (ctrl), (row_mask), 0xf, (bc)))
__device__ __forceinline__ float wave_max_dpp(float v) {
    v = fmaxf(v, dpp_f(v, v, DPP_ROW_SHR(1), 0xf, false)); v = fmaxf(v, dpp_f(v, v, DPP_ROW_SHR(2), 0xf, false));
    v = fmaxf(v, dpp_f(v, v, DPP_ROW_SHR(4), 0xf, false)); v = fmaxf(v, dpp_f(v, v, DPP_ROW_SHR(8), 0xf, false));
    v = fmaxf(v, dpp_f(v, v, DPP_ROW_BCAST15, 0xa, false)); v = fmaxf(v, dpp_f(v, v, DPP_ROW_BCAST31, 0xc, false));
    return __int_as_float(__builtin_amdgcn_readlane(__float_as_int(v), 63)); }
__device__ __forceinline__ float wave_min_dpp(float v) {
    v = fminf(v, dpp_f(v, v, DPP_ROW_SHR(1), 0xf, false)); v = fminf(v, dpp_f(v, v, DPP_ROW_SHR(2), 0xf, false));
    v = fminf(v, dpp_f(v, v, DPP_ROW_SHR(4), 0xf, false)); v = fminf(v, dpp_f(v, v, DPP_ROW_SHR(8), 0xf, false));
    v = fminf(v, dpp_f(v, v, DPP_ROW_BCAST15, 0xa, false)); v = fminf(v, dpp_f(v, v, DPP_ROW_BCAST31, 0xc, false));
    return __int_as_float(__builtin_amdgcn_readlane(__float_as_int(v), 63)); }
__device__ __forceinline__ unsigned wave_prefix_dpp(unsigned x, unsigned& tot, int lane) {
    int v = (int)x;
    v += __builtin_amdgcn_update_dpp(0, v, DPP_ROW_SHR(1), 0xf, 0xf, true);
    v += __builtin_amdgcn_update_dpp(0, v, DPP_ROW_SHR(2), 0xf, 0xf, true);
    v += __builtin_amdgcn_update_dpp(0, v, DPP_ROW_SHR(4), 0xf, 0xf, true);
    v += __builtin_amdgcn_update_dpp(0, v, DPP_ROW_SHR(8), 0xf, 0xf, true);
    const int t0 = __builtin_amdgcn_readlane(v, 15), t1 = __builtin_amdgcn_readlane(v, 31), t2 = __builtin_amdgcn_readlane(v, 47), t3 = __builtin_amdgcn_readlane(v, 63);
    const int rowi = lane >> 4;
    const int add = rowi == 0 ? 0 : (rowi == 1 ? t0 : (rowi == 2 ? t0 + t1 : t0 + t1 + t2));
    tot = (unsigned)(t0 + t1 + t2 + t3);
    return (unsigned)(v + add);
}

__device__ __forceinline__ unsigned ord16(float sc) { const unsigned h = (unsigned)__builtin_bit_cast(unsigned short, (f16)sc); const int m = __builtin_amdgcn_sbfe((int)h, 15, 1); return (h ^ ((unsigned)m | 0x8000u)) & 0xFFFFu; }
__device__ __forceinline__ void radix_find(const LAS unsigned* hist, int k, int lane, int& B, int& r) {
    const u32x4 hc = *(const LAS u32x4*)(hist + lane * 4);
    const unsigned s4 = hc.x + hc.y + hc.z + hc.w;
    unsigned tot; const unsigned pre = wave_prefix_dpp(s4, tot, lane);
    const unsigned above = tot - pre;
    const bool mine = (above < (unsigned)k) && (above + s4 >= (unsigned)k);
    int B1 = 0, r1 = 1;
    { unsigned c = above; const unsigned hb[4] = {hc.x, hc.y, hc.z, hc.w}; bool found = false;
#pragma unroll
      for (int b = 3; b >= 0; --b) { if (!found && c + hb[b] >= (unsigned)k) { B1 = lane * 4 + b; r1 = k - (int)c; found = true; } c += hb[b]; } }
    const u64 bmn = __ballot(mine);
    const int srcl = bmn ? (int)__builtin_ctzll(bmn) : 0;
    B = __builtin_amdgcn_readlane(B1, srcl); r = __builtin_amdgcn_readlane(r1, srcl);
}
__device__ __forceinline__ int wave_max_i_dpp(int v) {
    v = max(v, __builtin_amdgcn_update_dpp(v, v, DPP_ROW_SHR(1), 0xf, 0xf, false)); v = max(v, __builtin_amdgcn_update_dpp(v, v, DPP_ROW_SHR(2), 0xf, 0xf, false));
    v = max(v, __builtin_amdgcn_update_dpp(v, v, DPP_ROW_SHR(4), 0xf, 0xf, false)); v = max(v, __builtin_amdgcn_update_dpp(v, v, DPP_ROW_SHR(8), 0xf, 0xf, false));
    v = max(v, __builtin_amdgcn_update_dpp(v, v, DPP_ROW_BCAST15, 0xa, 0xf, false)); v = max(v, __builtin_amdgcn_update_dpp(v, v, DPP_ROW_BCAST31, 0xc, 0xf, false));
    return __builtin_amdgcn_readlane(v, 63); }
__device__ __forceinline__ int wave_min_i_dpp(int v) {
    v = min(v, __builtin_amdgcn_update_dpp(v, v, DPP_ROW_SHR(1), 0xf, 0xf, false)); v = min(v, __builtin_amdgcn_update_dpp(v, v, DPP_ROW_SHR(2), 0xf, 0xf, false));
    v = min(v, __builtin_amdgcn_update_dpp(v, v, DPP_ROW_SHR(4), 0xf, 0xf, false)); v = min(v, __builtin_amdgcn_update_dpp(v, v, DPP_ROW_SHR(8), 0xf, 0xf, false));
    v = min(v, __builtin_amdgcn_update_dpp(v, v, DPP_ROW_BCAST15, 0xa, 0xf, false)); v = min(v, __builtin_amdgcn_update_dpp(v, v, DPP_ROW_BCAST31, 0xc, 0xf, false));
    return __builtin_amdgcn_readlane(v, 63); }
__device__ __forceinline__ u64 wave_select_mask(const LAS unsigned short* S, int n, int k, LAS unsigned* hist, LAS u64* mb, int lane) {
    if (n <= k) { const int m_ = n - 64 * lane; return m_ >= 64 ? ~0ull : (m_ <= 0 ? 0ull : ((1ull << m_) - 1ull)); }
    int d[32]; int kmin = 0xFFFF, kmax = 0;
#pragma unroll
    for (int j = 0; j < 32; ++j) { const int idx = j * 64 + lane; const int key = (idx < n) ? (int)S[idx] : -1; d[j] = key; kmax = max(kmax, key); kmin = min(kmin, key < 0 ? 0xFFFF : key); }
    kmin = wave_min_i_dpp(kmin); kmax = wave_max_i_dpp(kmax);
    const int span = kmax - kmin;
    const int sh = span < 256 ? 0 : (24 - __builtin_clz((unsigned)span));
    const int dump = 256 + lane;
    *(LAS u32x4*)(hist + lane * 4) = (u32x4){0u, 0u, 0u, 0u};
    WSYNC();
#pragma unroll
    for (int j = 0; j < 32; ++j) { const bool ok = d[j] >= 0; d[j] = d[j] - kmin;
        __hip_atomic_fetch_add(&hist[ok ? (d[j] >> sh) : dump], 1u, __ATOMIC_RELAXED, __HIP_MEMORY_SCOPE_WORKGROUP); }
    WSYNC();
    int B1, r1; radix_find(hist, k, lane, B1, r1);
    WSYNC();
    *(LAS u32x4*)(hist + lane * 4) = (u32x4){0u, 0u, 0u, 0u};
    WSYNC();
    const int lowmask = (1 << sh) - 1;
#pragma unroll
    for (int j = 0; j < 32; ++j) { const bool in1 = (d[j] >= 0) && ((d[j] >> sh) == B1);
        __hip_atomic_fetch_add(&hist[in1 ? (d[j] & lowmask) : dump], 1u, __ATOMIC_RELAXED, __HIP_MEMORY_SCOPE_WORKGROUP); }
    WSYNC();
    int B2, r2; radix_find(hist, r1, lane, B2, r2);
    const int thr = (B1 << sh) + B2;
    WSYNC();
#pragma unroll
    for (int j = 0; j < 32; ++j) { const u64 bm = __ballot(d[j] >= thr); if (lane == 0) mb[j] = bm; }
    WSYNC();
    const u64 res = mb[lane & 31];
    WSYNC();
    return res;
}

__device__ __forceinline__ void qi_rope(h8& a0, const float* ROPE, int pos, int hh) {
    const float* rr = rope_row(ROPE, pos, 16);
    const f32x4 t0 = *(const f32x4*)rr, t1 = *(const f32x4*)(rr + 4), t2 = *(const f32x4*)(rr + 8), t3 = *(const f32x4*)(rr + 12);
    const float cs[16] = {t0[0], t0[1], t0[2], t0[3], t1[0], t1[1], t1[2], t1[3], t2[0], t2[1], t2[2], t2[3], t3[0], t3[1], t3[2], t3[3]};
#pragma unroll
    for (int jj = 0; jj < 8; ++jj) { const float c = cs[2 * jj], sn = cs[2 * jj + 1]; const float mine = (float)a0[jj], other = __shfl_xor(mine, 32);
        a0[jj] = (f16)(hh ? (mine * c + other * sn) : (mine * c - other * sn)); }
}
#define PHA_COMMON \
    const int tid = tid_fresh(), lane = tid & 63, wave = tid >> 6, r = lane & 31, hh = lane >> 5; \
    const f16* QI = (const f16*)(p.ws + WS_QI); const f16* KIH = (const f16*)(p.ws + WS_KIH); const float* WI = (const float*)(p.ws + WS_WI); \
    unsigned* MASK = (unsigned*)(p.ws + WS_MASK); float* SCS = (float*)(p.ws + WS_SCS); \
    const int qsel = (r >> 2) & 1, ahead = (r & 3) + 4 * (r >> 3); (void)tid; (void)MASK; (void)SCS; (void)KIH; (void)qsel; (void)ahead; (void)WI; (void)QI;
__device__ __forceinline__ void phA_sample(CParams& p, LAS unsigned char* lds, const int wv_s) {
    PHA_COMMON
    for (int it = blockIdx.x * 8 + wave; it < DB * NPG; it += gridDim.x * 8) {
        const int b = it / NPG, pg_ = it % NPG; const int phys = p.page_table[b * NPG + pg_];
        const float* kp0 = p.cache_ik + ((size_t)phys * PAGE + r) * 64 + 8 * hh;
        f32x4 raw[2][8];
#pragma unroll
        for (int s = 0; s < 4; ++s) { raw[0][2 * s] = *(const f32x4*)(kp0 + 16 * s); raw[0][2 * s + 1] = *(const f32x4*)(kp0 + 16 * s + 4); }
        h8 af[2][4]; float wv[2][16];
#pragma unroll
        for (int mt = 0; mt < 2; ++mt) {
            const int rowa = MP + b * 4 + 2 * mt + qsel, roww = MP + b * 4 + 2 * mt + hh;
#pragma unroll
            for (int s = 0; s < 4; ++s) af[mt][s] = *(const h8*)(QI + (size_t)rowa * D + ahead * 64 + 16 * s + 8 * hh);
            qi_rope(af[mt][0], (const float*)(p.ws + WS_ROPE), PAST + 2 * mt + qsel, hh);
#pragma unroll
            for (int q4 = 0; q4 < 4; ++q4) { const f32x4 w4 = *(const f32x4*)(WI + (size_t)roww * 16 + q4 * 4); wv[mt][q4 * 4] = w4[0]; wv[mt][q4 * 4 + 1] = w4[1]; wv[mt][q4 * 4 + 2] = w4[2]; wv[mt][q4 * 4 + 3] = w4[3]; }
        }
#pragma unroll
        for (int kt = 0; kt < 4; ++kt) {
            if (kt < 3) { const float* kp = kp0 + (size_t)(kt + 1) * 32 * 64;
#pragma unroll
                for (int s = 0; s < 4; ++s) { raw[(kt + 1) & 1][2 * s] = *(const f32x4*)(kp + 16 * s); raw[(kt + 1) & 1][2 * s + 1] = *(const f32x4*)(kp + 16 * s + 4); } }
            h8 bf[4];
#pragma unroll
            for (int s = 0; s < 4; ++s) { const f32x4 a = raw[kt & 1][2 * s], c = raw[kt & 1][2 * s + 1];
                bf[s][0] = (f16)a[0]; bf[s][1] = (f16)a[1]; bf[s][2] = (f16)a[2]; bf[s][3] = (f16)a[3]; bf[s][4] = (f16)c[0]; bf[s][5] = (f16)c[1]; bf[s][6] = (f16)c[2]; bf[s][7] = (f16)c[3]; }
#pragma unroll
            for (int mt = 0; mt < 2; ++mt) {
                f32x16 acc;
#pragma unroll
                for (int e = 0; e < 16; ++e) acc[e] = 0.f;
#pragma unroll
                for (int s = 0; s < 4; ++s) acc = __builtin_amdgcn_mfma_f32_32x32x16_f16(af[mt][s], bf[s], acc, 0, 0, 0);
                float sc = 0.f;
#pragma unroll
                for (int e = 0; e < 16; ++e) sc += wv[mt][e] * relu_f(acc[e]);
                SCS[(size_t)(b * 4 + 2 * mt + hh) * LSP + pg_ * PAGE + kt * 32 + r] = sc;
            }
        }
    }
    for (int b = blockIdx.x * 8 + wave; b < DB; b += gridDim.x * 8) {
        const int t = lane >> 4, h = lane & 15; const int rowq = MP + b * 4 + t;
        const float w = WI[(size_t)rowq * 16 + h];
        float dots[4] = {0.f, 0.f, 0.f, 0.f};
        h8 qr0 = *(const h8*)(QI + (size_t)rowq * D + h * 64), qr1 = *(const h8*)(QI + (size_t)rowq * D + h * 64 + 8);
#pragma unroll
        for (int jj = 0; jj < 8; ++jj) { const float* rr = rope_row((const float*)(p.ws + WS_ROPE), PAST + t, 16 + jj); const float c = rr[0], sn = rr[1]; const float x1 = (float)qr0[jj], x2 = (float)qr1[jj]; qr0[jj] = (f16)(x1 * c - x2 * sn); qr1[jj] = (f16)(x2 * c + x1 * sn); }
        for (int d0 = 0; d0 < 64; d0 += 8) {
            const h8 qv = d0 == 0 ? qr0 : (d0 == 8 ? qr1 : *(const h8*)(QI + (size_t)rowq * D + h * 64 + d0));
#pragma unroll
            for (int t2 = 0; t2 < 4; ++t2) { const h8 kv = *(const h8*)(KIH + (size_t)(MP + b * 4 + t2) * 64 + d0);
#pragma unroll
                for (int j = 0; j < 8; ++j) dots[t2] += (float)qv[j] * (float)kv[j]; }
        }
#pragma unroll
        for (int t2 = 0; t2 < 4; ++t2) { float s = w * fmaxf(dots[t2], 0.f);
            s += __shfl_xor(s, 1); s += __shfl_xor(s, 2); s += __shfl_xor(s, 4); s += __shfl_xor(s, 8);
            if (h == 0) SCS[(size_t)(b * 4 + t) * LSP + PAST + t2] = (t2 <= t) ? s : -3.0e38f; }
    }
}
template <bool SELECT> __device__ __forceinline__ void phA_prompt(CParams& p, LAS unsigned char* lds, const int wv_s) {
    PHA_COMMON
    LAS unsigned short* S = (LAS unsigned short*)lds + wave * 8192;
    LAS unsigned* hist = (LAS unsigned*)(lds + LDS_AUX + wave * 1536);
    LAS u64* mb = (LAS u64*)(lds + LDS_AUX + wave * 1536 + 1280);
    const float* ROPE = (const float*)(p.ws + WS_ROPE);
    if (blockIdx.x < 256)
    for (int j = 0; j < 4; ++j) {
        const int wq = blockIdx.x >> 4, b = blockIdx.x & 15;
        const int qt = (j == 0) ? wq : (j == 1 ? 31 - wq : (j == 2 ? 32 + wq : 63 - wq));
        const int q0 = qt * 32 + 4 * wv_s;
        const size_t tok0 = (size_t)b * SEQ;
        h8 af[2][4]; float wv[2][16];
#pragma unroll
        for (int mt = 0; mt < 2; ++mt) {
#pragma unroll
            for (int s = 0; s < 4; ++s) af[mt][s] = *(const h8*)(QI + (tok0 + q0 + 2 * mt + qsel) * D + ahead * 64 + 16 * s + 8 * hh);
            qi_rope(af[mt][0], ROPE, q0 + 2 * mt + qsel, hh);
#pragma unroll
            for (int q4 = 0; q4 < 4; ++q4) { const f32x4 w4 = *(const f32x4*)(WI + (tok0 + q0 + 2 * mt + hh) * 16 + q4 * 4); wv[mt][q4 * 4] = w4[0]; wv[mt][q4 * 4 + 1] = w4[1]; wv[mt][q4 * 4 + 2] = w4[2]; wv[mt][q4 * 4 + 3] = w4[3]; }
        }
        const int nkt = (q0 + 3) / 32 + 1;
        const f16* kbase = KIH + (size_t)b * 64 * 2048; const unsigned loff = (unsigned)lane * 8u;
        h8 bq[4][4];
#pragma unroll
        for (int u = 0; u < 4; ++u) { const int kk = u < nkt ? u : nkt - 1; const f16* kp = kbase + (size_t)kk * 2048;
#pragma unroll
            for (int s = 0; s < 4; ++s) bq[u][s] = *(const h8*)(kp + loff + 512 * s); }
#define IX_CHAIN(ACC, MT, BQ) { _Pragma("unroll") for (int e = 0; e < 16; ++e) ACC[e] = 0.f; \
        _Pragma("unroll") for (int s = 0; s < 4; ++s) ACC = __builtin_amdgcn_mfma_f32_32x32x16_f16(af[MT][s], BQ[s], ACC, 0, 0, 0); }
#define IX_SUM(ACC, MT, KT) { float sa = 0.f, sb = 0.f; _Pragma("unroll") for (int e = 0; e < 16; e += 2) { sa += wv[MT][e] * relu_f(ACC[e]); sb += wv[MT][e + 1] * relu_f(ACC[e + 1]); } \
        S[(2 * (MT) + hh) * 2048 + (KT) * 32 + r] = (unsigned short)ord16(sa + sb); }
#define IX_MIX() { _Pragma("unroll") for (int i = 0; i < 4; ++i) { __builtin_amdgcn_sched_group_barrier(0x008, 1, 0); __builtin_amdgcn_sched_group_barrier(0x002, 8, 0); } }
        f32x16 accA, accB;
        IX_CHAIN(accA, 0, bq[0])
        for (int kt0 = 0; kt0 < nkt; kt0 += 4) {
#pragma unroll
            for (int u = 0; u < 4; ++u) {
                const int kt = kt0 + u, un = (u + 1) & 3;
                IX_CHAIN(accB, 1, bq[u])
                IX_SUM(accA, 0, kt)
                IX_MIX()
                { const int kn = kt + 4; const int kk = kn < nkt ? kn : nkt - 1; const f16* kp = kbase + (size_t)kk * 2048;
#pragma unroll
                  for (int s = 0; s < 4; ++s) bq[u][s] = *(const h8*)(kp + loff + 512 * s); }
                IX_CHAIN(accA, 0, bq[un])
                IX_SUM(accB, 1, kt)
                IX_MIX()
            }
        }
#undef IX_CHAIN
#undef IX_SUM
#undef IX_MIX
        WSYNC();
        if (SELECT)
        for (int qq = 0; qq < 4; ++qq) {
            const int pos = q0 + qq; const int n = pos + 1;
            const u64 mine = wave_select_mask(S + qq * 2048, n, 256, hist, mb, lane);
            if (lane < 32) *(u64*)(MASK + (tok0 + pos) * 64 + lane * 2) = mine;
        }
        WSYNC();
    }
}

__device__ __forceinline__ void phB_sample(CParams& p, LAS unsigned char* lds, const int wv_s) {
    const int tid = tid_fresh(), lane = tid & 63, wave = tid >> 6;
    if (blockIdx.x >= MS) return;
    const int row = blockIdx.x;
    const int b = row >> 2, t = row & 3; const int n = PAST + t + 1;
    LAS unsigned* hist = (LAS unsigned*)(lds + LDS_AUX);
    LAS float* cand = (LAS float*)(lds + LDS_AUX + 4096);
    LAS float* red = (LAS float*)(lds + LDS_AUX + 4352);
    LAS int* idxl = (LAS int*)(lds + LDS_AUX + 4864);
    LAS int* rowl = (LAS int*)(lds + LDS_AUX + 5888);
    LAS float* qs = (LAS float*)(lds + LDS_AUX + 6912);
    LAS float* s2 = (LAS float*)(lds + LDS_AUX + 11008);
    LAS unsigned* cnt = (LAS unsigned*)(red + 16);
    const float* SCS = (const float*)(p.ws + WS_SCS) + (size_t)row * LSP;
    const f16* Q = (const f16*)(p.ws + WS_Q) + (size_t)(MP + row) * D;
    constexpr int NV = 33;
    float v[NV];
#pragma unroll
    for (int j = 0; j < NV; ++j) { const int i = j * NTHR + tid; v[j] = (i < n) ? SCS[i] : -3.0e38f; }
    __syncthreads();
    qs[tid] = (float)Q[tid]; qs[tid + NTHR] = (float)Q[tid + NTHR];
    if (tid < 256) { idxl[tid] = -1; rowl[tid] = 0; }
    __syncthreads();
    {
        const float a = qs[wave * 128 + lane], b2 = qs[wave * 128 + 64 + lane];
        const float rn = rsqrtf(wave_sum(a * a + b2 * b2) * (1.f / 128.f) + EPS) * 0.12751743f;
        float ya = a * rn * p.q_norm[lane], yb = b2 * rn * p.q_norm[64 + lane];
        const float oth = __shfl_xor(ya, 16);
        if (lane < 32) { const float* rr = rope_row((const float*)(p.ws + WS_ROPE), PAST + t, lane & 15); const float c = rr[0], sn = rr[1]; ya = lane < 16 ? (ya * c - oth * sn) : (ya * c + oth * sn); }
        qs[wave * 128 + lane] = ya; qs[wave * 128 + 64 + lane] = yb;
    }
    float lo = 3.0e38f, hi = -3.0e38f;
#pragma unroll
    for (int j = 0; j < NV; ++j) { hi = fmaxf(hi, v[j]); lo = fminf(lo, (j * NTHR + tid < n) ? v[j] : 3.0e38f); }
    lo = wave_min_dpp(lo); hi = wave_max_dpp(hi);
    if (lane == 0) { red[wave] = lo; red[8 + wave] = hi; }
    __syncthreads();
    lo = red[0]; hi = red[8];
#pragma unroll
    for (int w = 1; w < 8; ++w) { lo = fminf(lo, red[w]); hi = fmaxf(hi, red[8 + w]); }
    float thr = lo; int k = 256;
    for (int iter = 0; iter < 12; ++iter) {
        if (!(hi > lo)) { thr = lo; break; }
        const float scale = 1024.0f / (hi - lo);
        __syncthreads();
        if (tid < 256) *(LAS u32x4*)(hist + tid * 4) = (u32x4){0u, 0u, 0u, 0u};
        if (tid == 0) *cnt = 0u;
        __syncthreads();
#pragma unroll
        for (int j = 0; j < NV; ++j) { const float x = v[j];
            if (x >= lo && x <= hi) { int bb = (int)((x - lo) * scale); bb = bb > 1023 ? 1023 : bb; __hip_atomic_fetch_add(&hist[bb], 1u, __ATOMIC_RELAXED, __HIP_MEMORY_SCOPE_WORKGROUP); } }
        __syncthreads();
        u32x4 hc[4]; unsigned s16 = 0u;
#pragma unroll
        for (int q = 0; q < 4; ++q) { hc[q] = *(const LAS u32x4*)(hist + lane * 16 + q * 4); s16 += hc[q].x + hc[q].y + hc[q].z + hc[q].w; }
        unsigned tot; const unsigned pre = wave_prefix_dpp(s16, tot, lane);
        const unsigned above = tot - pre;
        const bool mine = (above < (unsigned)k) && (above + s16 >= (unsigned)k);
        int B1 = 0, r = 1, m = 0;
        { unsigned c = above; bool found = false;
#pragma unroll
          for (int q = 3; q >= 0; --q) { const unsigned hb[4] = {hc[q].x, hc[q].y, hc[q].z, hc[q].w};
#pragma unroll
            for (int e = 3; e >= 0; --e) { if (!found && c + hb[e] >= (unsigned)k) { B1 = lane * 16 + q * 4 + e; r = k - (int)c; m = (int)hb[e]; found = true; } c += hb[e]; } } }
        const u64 bmn = __ballot(mine);
        const int srcl = bmn ? (int)__builtin_ctzll(bmn) : 0;
        B1 = __builtin_amdgcn_readlane(B1, srcl); r = __builtin_amdgcn_readlane(r, srcl); m = __builtin_amdgcn_readlane(m, srcl);
        if (m <= 64) {
            if (tid < 64) cand[tid] = -3.0e38f;
            __syncthreads();
#pragma unroll
            for (int j = 0; j < NV; ++j) { const float x = v[j];
                if (x >= lo && x <= hi) { int bb = (int)((x - lo) * scale); bb = bb > 1023 ? 1023 : bb;
                    if (bb == B1) { const unsigned slot = __hip_atomic_fetch_add(cnt, 1u, __ATOMIC_RELAXED, __HIP_MEMORY_SCOPE_WORKGROUP); if (slot < 64u) cand[slot] = x; } } }
            __syncthreads();
            const float c = cand[lane]; int gt = 0, ge = 0;
            const int m4 = (m + 3) >> 2;
            for (int j4 = 0; j4 < m4; ++j4) { const f32x4 cj = *(const LAS f32x4*)(cand + j4 * 4);
#pragma unroll
                for (int e = 0; e < 4; ++e) { gt += (cj[e] > c) ? 1 : 0; ge += (cj[e] >= c) ? 1 : 0; } }
            const u64 bm2 = __ballot(lane < m && gt < r && ge >= r);
            const int s2l = bm2 ? (int)__builtin_ctzll(bm2) : 0;
            thr = __int_as_float(__builtin_amdgcn_readlane(__float_as_int(c), s2l));
            break;
        } else {
            float nlo = 3.0e38f, nhi = -3.0e38f;
#pragma unroll
            for (int j = 0; j < NV; ++j) { const float x = v[j];
                if (x >= lo && x <= hi) { int bb = (int)((x - lo) * scale); bb = bb > 1023 ? 1023 : bb; if (bb == B1) { nlo = fminf(nlo, x); nhi = fmaxf(nhi, x); } } }
            nlo = wave_min_dpp(nlo); nhi = wave_max_dpp(nhi);
            if (lane == 0) { red[32 + wave] = nlo; red[40 + wave] = nhi; }
            __syncthreads();
            lo = red[32]; hi = red[40];
#pragma unroll
            for (int w = 1; w < 8; ++w) { lo = fminf(lo, red[32 + w]); hi = fmaxf(hi, red[40 + w]); }
            k = r; thr = lo;
        }
    }
    {
        int cntw = 0;
#pragma unroll
        for (int j = 0; j < NV; ++j) cntw += __popcll(__ballot((j * NTHR + tid < n) && (v[j] >= thr)));
        LAS int* wc = (LAS int*)(red + 48);
        __syncthreads();
        if (lane == 0) wc[wave] = cntw;
        __syncthreads();
        int base = 0;
        for (int w = 0; w < wave; ++w) base += wc[w];
#pragma unroll
        for (int j = 0; j < NV; ++j) { const bool sel = (j * NTHR + tid < n) && (v[j] >= thr);
            const u64 bm = __ballot(sel);
            if (sel) { const int slot = base + __popcll(bm & ((1ull << lane) - 1ull)); if (slot < 256) idxl[slot] = j * NTHR + tid; }
            base += __popcll(bm); }
    }
    __syncthreads();
    if (tid < 256) { const int idx = idxl[tid]; int ro = 0;
        if (idx >= 0) { if (idx < PAST) ro = p.page_table[b * NPG + (idx >> 7)] * PAGE + (idx & 127); else ro = -(idx - PAST + 1); }
        rowl[tid] = ro; }
    __syncthreads();
    for (int kv = 0; kv < 2; ++kv) {
    {
        const int slot = tid >> 1, dh = tid & 1; const int idx = idxl[slot]; const int ro = rowl[slot];
        float a4[4] = {0.f, 0.f, 0.f, 0.f};
        if (idx >= 0) {
            const float* kp = ((ro >= 0) ? p.cache_k + (size_t)ro * 256 : p.out + O_KS + (size_t)(b * 4 + (-ro - 1)) * 256) + kv * 128 + dh * 64;
            f32x4 kk[16];
#pragma unroll
            for (int c = 0; c < 16; ++c) kk[c] = *(const f32x4*)(kp + c * 4);
#pragma unroll
            for (int c = 0; c < 16; ++c)
#pragma unroll
                for (int h = 0; h < 4; ++h) { const f32x4 qh = *(const LAS f32x4*)(qs + (kv * 4 + h) * 128 + dh * 64 + c * 4); a4[h] += kk[c][0] * qh[0] + kk[c][1] * qh[1] + kk[c][2] * qh[2] + kk[c][3] * qh[3]; }
        }
#pragma unroll
        for (int h = 0; h < 4; ++h) { a4[h] += __shfl_xor(a4[h], 1); if (dh == 0) s2[h * 256 + slot] = idx >= 0 ? a4[h] : -3.0e38f; }
    }
    __syncthreads();
    if (wave < 4) {
        LAS float* sh = s2 + wave * 256; float x[4]; float mx = -3.0e38f;
#pragma unroll
        for (int i = 0; i < 4; ++i) { x[i] = sh[i * 64 + lane]; mx = fmaxf(mx, x[i]); }
        mx = wave_max(mx); float sum = 0.f;
#pragma unroll
        for (int i = 0; i < 4; ++i) { x[i] = (x[i] > -1.0e38f) ? __builtin_amdgcn_exp2f(x[i] - mx) : 0.f; sum += x[i]; }
        sum = wave_sum(sum); const float inv = 1.f / sum;
#pragma unroll
        for (int i = 0; i < 4; ++i) sh[i * 64 + lane] = x[i] * inv;
    }
    LAS float* Vs = (LAS float*)lds;
    { const int slot = tid >> 1, half = tid & 1; const int ro = rowl[slot];
      const float* vp = ((ro >= 0) ? p.cache_v + (size_t)ro * 256 : p.out + O_VS + (size_t)(b * 4 + (-ro - 1)) * 256) + kv * 128 + half * 64;
      f32x4 tmp[16];
#pragma unroll
      for (int c = 0; c < 16; ++c) tmp[c] = *(const f32x4*)(vp + c * 4);
#pragma unroll
      for (int c = 0; c < 16; ++c) *(LAS f32x4*)(Vs + slot * 128 + half * 64 + c * 4) = tmp[c]; }
    __syncthreads();
    { const int hl = tid >> 7, d = tid & 127, head = kv * 4 + hl; float o = 0.f;
      const LAS float* ph = s2 + hl * 256;
#pragma unroll 8
      for (int slot = 0; slot < 256; ++slot) o += ph[slot] * Vs[slot * 128 + d];
      const size_t oi = (size_t)(MP + row) * D + head * 128 + d;
      ((f16*)(p.ws + WS_AOS))[as16_off(row, head * 128 + d)] = (f16)(o * silu_f((float)((const f16*)(p.ws + WS_SG))[oi])); }
    __syncthreads();
    }
}

__device__ __forceinline__ void q_prep(h8 (&qf)[8], const float* qn, const float* ROPE, int pos, int hh) {
    float ss = 0.f;
#pragma unroll
    for (int s = 0; s < 8; ++s)
#pragma unroll
        for (int jj = 0; jj < 8; ++jj) { const float x = (float)qf[s][jj]; ss += x * x; }
    ss += __shfl_xor(ss, 32);
    const float rn = rsqrtf(ss * (1.f / 128.f) + EPS) * 0.12751743f;
    float y0[8], y1[8];
    { const f32x4 g0 = *(const f32x4*)(qn + 8 * hh), g1 = *(const f32x4*)(qn + 8 * hh + 4), g2 = *(const f32x4*)(qn + 16 + 8 * hh), g3 = *(const f32x4*)(qn + 16 + 8 * hh + 4);
#pragma unroll
      for (int jj = 0; jj < 8; ++jj) { y0[jj] = (float)qf[0][jj] * rn * (jj < 4 ? g0[jj & 3] : g1[jj & 3]); y1[jj] = (float)qf[1][jj] * rn * (jj < 4 ? g2[jj & 3] : g3[jj & 3]); } }
#pragma unroll
    for (int s = 2; s < 8; ++s)
#pragma unroll
        for (int jj = 0; jj < 8; ++jj) qf[s][jj] = (f16)((float)qf[s][jj] * rn);
    const float* rr = rope_row(ROPE, pos, 8 * hh);
    const f32x4 t0 = *(const f32x4*)rr, t1 = *(const f32x4*)(rr + 4), t2 = *(const f32x4*)(rr + 8), t3 = *(const f32x4*)(rr + 12);
    const float cs[16] = {t0[0], t0[1], t0[2], t0[3], t1[0], t1[1], t1[2], t1[3], t2[0], t2[1], t2[2], t2[3], t3[0], t3[1], t3[2], t3[3]};
#pragma unroll
    for (int jj = 0; jj < 8; ++jj) { const float c = cs[2 * jj], sn = cs[2 * jj + 1]; qf[0][jj] = (f16)(y0[jj] * c - y1[jj] * sn); qf[1][jj] = (f16)(y1[jj] * c + y0[jj] * sn); }
}

__device__ __forceinline__ float xhalf_max(float x) { const auto r = __builtin_amdgcn_permlane32_swap(__float_as_uint(x), __float_as_uint(x), false, false); return fmaxf(__uint_as_float(r[0]), __uint_as_float(r[1])); }
__device__ __forceinline__ float xhalf_sum(float x) { const auto r = __builtin_amdgcn_permlane32_swap(__float_as_uint(x), __float_as_uint(x), false, false); return __uint_as_float(r[0]) + __uint_as_float(r[1]); }
__device__ __forceinline__ void attn_tile64(const LAS f16* kb, const LAS f16* vb, unsigned mlo, unsigned mhi, const h8 (&qf)[8], f32x16 (&oacc)[4], float& mrun, float& lrun, int r, int hh) {
    constexpr int KROW = 136, VROW = 72;
    f32x16 sacc[2];
#pragma unroll
    for (int kb2 = 0; kb2 < 2; ++kb2) {
#pragma unroll
        for (int e = 0; e < 16; ++e) sacc[kb2][e] = 0.f;
#pragma unroll
        for (int s = 0; s < 8; ++s) { const h8 kf = *(const LAS h8*)(kb + (32 * kb2 + r) * KROW + 16 * s + 8 * hh); sacc[kb2] = __builtin_amdgcn_mfma_f32_32x32x16_f16(kf, qf[s], sacc[kb2], 0, 0, 0); }
    }
    float sv[32]; float mx = -3.0e38f;
#pragma unroll
    for (int kb2 = 0; kb2 < 2; ++kb2) {
        const int mwb = (int)((kb2 ? mhi : mlo) >> (4 * hh));
#pragma unroll
        for (int e = 0; e < 16; ++e) {
            const int t = __builtin_amdgcn_sbfe(mwb, (e & 3) + 8 * (e >> 2), 1);
            const int sb = (__float_as_int(sacc[kb2][e]) & t) | ((int)0xFF800000 & ~t);
            sv[16 * kb2 + e] = __int_as_float(sb); mx = fmaxf(mx, sv[16 * kb2 + e]);
        }
    }
    mx = xhalf_max(mx);
    if (__any(mx - mrun > 8.f)) {
        const float mnew = fmaxf(mrun, mx); const float alpha = __builtin_amdgcn_exp2f(mrun - mnew);
        lrun *= alpha; mrun = mnew;
#pragma unroll
        for (int mt = 0; mt < 4; ++mt)
#pragma unroll
            for (int e = 0; e < 16; ++e) oacc[mt][e] *= alpha;
    }
    float rsum = 0.f;
#pragma unroll
    for (int e = 0; e < 32; ++e) { sv[e] = __builtin_amdgcn_exp2f(sv[e] - mrun); rsum += sv[e]; }
    rsum = xhalf_sum(rsum);
    lrun += rsum;
    typedef _Float16 h2t __attribute__((ext_vector_type(2)));
    h8 pf[4];
#pragma unroll
    for (int s2 = 0; s2 < 4; ++s2)
#pragma unroll
        for (int jj = 0; jj < 4; ++jj) { const h2t pk = __builtin_bit_cast(h2t, __builtin_amdgcn_cvt_pkrtz(sv[8 * s2 + 2 * jj], sv[8 * s2 + 2 * jj + 1])); pf[s2][2 * jj] = pk[0]; pf[s2][2 * jj + 1] = pk[1]; }
#pragma unroll
    for (int mt = 0; mt < 4; ++mt)
#pragma unroll
        for (int s2 = 0; s2 < 4; ++s2) {
            const h8 vf = *(const LAS h8*)(vb + (32 * mt + r) * VROW + 16 * s2 + 8 * hh);
            oacc[mt] = __builtin_amdgcn_mfma_f32_32x32x16_f16(vf, pf[s2], oacc[mt], 0, 0, 0);
        }
}

__device__ __forceinline__ void phB_attention(CParams& p, LAS unsigned char* lds, const int wv_s) {
    const int tid = tid_fresh(), lane = tid & 63, wave = tid >> 6, r = lane & 31, hh = lane >> 5;
    const f16* Q = (const f16*)(p.ws + WS_Q); const f16* KH = (const f16*)(p.ws + WS_KH); const f16* VT = (const f16*)(p.ws + WS_VT);
    const f16* SG = (const f16*)(p.ws + WS_SG); f16* AO = (f16*)(p.ws + WS_AO); const unsigned* MASK = (const unsigned*)(p.ws + WS_MASK);
    constexpr int KROW = 136, VROW = 72;
    constexpr int KBUF = 64 * KROW, VBUF = 128 * VROW;
    LAS f16* Kb = (LAS f16*)lds;
    LAS f16* Vb = (LAS f16*)(lds + 2 * KBUF * 2);
    LAS u64* MK = (LAS u64*)(lds + 2 * KBUF * 2 + 2 * VBUF * 2) + wave * 256;
    if (blockIdx.x >= 256) return;
    for (int j = 0; j < 4; ++j) {
        const int bk = blockIdx.x & 31, b = bk >> 1, kvh = bk & 1, x = blockIdx.x >> 5;
        const int y = x & 3;
        const int qt = x < 4 ? (j == 0 ? y : (j == 1 ? 15 - y : (j == 2 ? 16 + y : 23 - y))) : (j == 0 ? 4 + y : (j == 1 ? 11 - y : (j == 2 ? 24 + y : 31 - y)));
        const int q0 = qt * 64; const size_t tok0 = (size_t)b * SEQ;
        const int query = q0 + 8 * wave + (r >> 2), head = kvh * 4 + (r & 3);
        h8 qf[8];
#pragma unroll
        for (int s = 0; s < 8; ++s) qf[s] = *(const h8*)(Q + (tok0 + query) * D + head * 128 + 16 * s + 8 * hh);
        q_prep(qf, p.q_norm, (const float*)(p.ws + WS_ROPE), query, hh);
        f32x16 oacc[4];
#pragma unroll
        for (int mt = 0; mt < 4; ++mt)
#pragma unroll
            for (int e = 0; e < 16; ++e) oacc[mt][e] = 0.f;
        float mrun = -1.0e30f, lrun = 0.f;
        const int nkt = qt + 1;
        const f16* kg = KH + (tok0 + (tid >> 4)) * 256 + kvh * 128 + (tid & 15) * 8;
        const f16* vg = VT + ((size_t)(b * 2 + kvh) * 128 + (tid >> 3)) * SEQ + (tid & 7) * 8;
        LAS f16* kl = Kb + (tid >> 4) * KROW + (tid & 15) * 8;
        LAS f16* vl = Vb + (tid >> 3) * VROW + (tid & 7) * 8;
        __syncthreads();
        h8 k0 = *(const h8*)kg, k1 = *(const h8*)(kg + (size_t)32 * 256), v0 = *(const h8*)vg, v1 = *(const h8*)(vg + (size_t)64 * SEQ);
        {
            const int mq = lane >> 3; const u64* mgq = (const u64*)(MASK + (tok0 + q0 + 8 * wave + mq) * 64);
#pragma unroll
            for (int i = 0; i < 4; ++i) { const int tl = (lane & 7) + 8 * i; if (tl < nkt) MK[mq * 32 + tl] = mgq[tl]; }
        }
        *(LAS h8*)kl = k0; *(LAS h8*)(kl + 32 * KROW) = k1; *(LAS h8*)vl = v0; *(LAS h8*)(vl + 64 * VROW) = v1;
#define AT_GLD(DST, PTR) asm volatile("global_load_dwordx4 %0, %1, off" : "=v"(DST) : "v"(PTR) : "memory")
#define AT_LOAD(K0, K1, V0, V1, T) { const int ti_ = (T) < nkt ? (T) : nkt - 1; const f16* kgn = kg + (size_t)ti_ * 64 * 256; const f16* vgn = vg + ti_ * 64; \
            AT_GLD(K0, kgn); AT_GLD(K1, kgn + (size_t)32 * 256); AT_GLD(V0, vgn); AT_GLD(V1, vgn + (size_t)64 * SEQ); }
#define AT_WAIT(N, K0, K1, V0, V1) asm volatile("s_waitcnt vmcnt(" #N ")" : "+v"(K0), "+v"(K1), "+v"(V0), "+v"(V1) :: "memory")
#define AT_STORE(K0, K1, V0, V1, BUF) { LAS f16* kl2 = kl + (BUF) * KBUF; LAS f16* vl2 = vl + (BUF) * VBUF; \
            *(LAS u32x4*)kl2 = K0; *(LAS u32x4*)(kl2 + 32 * KROW) = K1; *(LAS u32x4*)vl2 = V0; *(LAS u32x4*)(vl2 + 64 * VROW) = V1; }
        u32x4 ka0, ka1, va0, va1, kb0, kb1, vb0, vb1;
        asm volatile("s_waitcnt vmcnt(0)" ::: "memory");
        AT_LOAD(ka0, ka1, va0, va1, 1)
        AT_LOAD(kb0, kb1, vb0, vb1, 2)
        __syncthreads();
        for (int kt = 0; kt < nkt; kt += 2) {
            { const u64 mcur = MK[(r >> 2) * 32 + kt];
              attn_tile64(Kb, Vb, (unsigned)mcur, (unsigned)(mcur >> 32), qf, oacc, mrun, lrun, r, hh); }
            AT_WAIT(4, ka0, ka1, va0, va1);
            AT_STORE(ka0, ka1, va0, va1, 1)
            AT_LOAD(ka0, ka1, va0, va1, kt + 3)
            __syncthreads();
            if (kt + 1 >= nkt) break;
            { const u64 mcur = MK[(r >> 2) * 32 + kt + 1];
              attn_tile64(Kb + KBUF, Vb + VBUF, (unsigned)mcur, (unsigned)(mcur >> 32), qf, oacc, mrun, lrun, r, hh); }
            AT_WAIT(4, kb0, kb1, vb0, vb1);
            AT_STORE(kb0, kb1, vb0, vb1, 0)
            AT_LOAD(kb0, kb1, vb0, vb1, kt + 4)
            __syncthreads();
        }
        asm volatile("s_waitcnt vmcnt(0)" : "+v"(ka0), "+v"(ka1), "+v"(va0), "+v"(va1), "+v"(kb0), "+v"(kb1), "+v"(vb0), "+v"(vb1) :: "memory");
#undef AT_GLD
#undef AT_LOAD
#undef AT_WAIT
#undef AT_STORE
        const float invl = 1.f / lrun;
        const size_t obase = (tok0 + query) * D + head * 128;
#pragma unroll
        for (int mt = 0; mt < 4; ++mt)
#pragma unroll
            for (int g4 = 0; g4 < 4; ++g4) {
                const int d = 32 * mt + 8 * g4 + 4 * hh;
                const h4 sg = *(const h4*)(SG + obase + d); h4 o;
#pragma unroll
                for (int e = 0; e < 4; ++e) o[e] = (f16)(oacc[mt][4 * g4 + e] * invl * silu_f((float)sg[e]));
                *(h4*)(AO + obase + d) = o;
            }
    }
}

__device__ __forceinline__ f32x4 ld_h4f(const f16* p_) { const h4 t = *(const h4*)p_; return (f32x4){(float)t[0], (float)t[1], (float)t[2], (float)t[3]}; }
__device__ __forceinline__ void ph_conv(CParams& p, const int wv_s) {
    const f16* XB = (const f16*)(p.ws + WS_XB); f16* XC = (f16*)(p.ws + WS_XC);
    const long gtid = (long)blockIdx.x * NTHR + tid_fresh(), gth = (long)gridDim.x * NTHR;
    constexpr int RUN = 16, NRUN = MT / RUN;
    for (long it = gtid; it < (long)NRUN * 256; it += gth) {
        const int run = (int)(it >> 8), c = (int)(it & 255) * 4, row0 = run * RUN;
        const f32x4 w0 = *(const f32x4*)(p.conv_w + c), w1 = *(const f32x4*)(p.conv_w + D + c), w2 = *(const f32x4*)(p.conv_w + 2 * D + c), w3 = *(const f32x4*)(p.conv_w + 3 * D + c);
        const f32x4 bias = *(const f32x4*)(p.conv_b + c);
        const f32x4 z4 = (f32x4){0.f, 0.f, 0.f, 0.f};
        f32x4 xm1 = z4, xm2 = z4, xm3 = z4;
        if (row0 < MP) { if ((row0 & (SEQ - 1)) != 0) { xm1 = ld_h4f(XB + (size_t)(row0 - 1) * D + c); xm2 = ld_h4f(XB + (size_t)(row0 - 2) * D + c); xm3 = ld_h4f(XB + (size_t)(row0 - 3) * D + c); } }
#pragma unroll
        for (int i = 0; i < RUN; ++i) {
            const int row = row0 + i;
            const f32x4 x0 = ld_h4f(XB + (size_t)row * D + c);
            if (row < MP) { const int pos = row & (SEQ - 1);
                if (pos >= SEQ - 3) *(f32x4*)(p.out + O_CP + ((size_t)(row >> 11) * 3 + (pos - (SEQ - 3))) * D + c) = x0;
            } else { const int rs = row - MP, b = rs >> 2, t = rs & 3;
                if (t == 0) { const float* st = p.st_conv + (size_t)b * 3 * D + c; xm3 = *(const f32x4*)st; xm2 = *(const f32x4*)(st + D); xm1 = *(const f32x4*)(st + 2 * D); }
                else *(f32x4*)(p.out + O_CS + ((size_t)b * 3 + (t - 1)) * D + c) = x0;
            }
            const f32x4 y = w3 * x0 + w2 * xm1 + w1 * xm2 + w0 * xm3 + bias;
            *(h4*)(XC + (size_t)row * D + c) = to_h4(y);
            if (row >= MP) *(h4*)((f16*)(p.ws + WS_XCS) + as16_off(row - MP, c)) = to_h4(y);
            xm3 = xm2; xm2 = xm1; xm1 = x0;
        }
    }
}

__device__ __forceinline__ void ph_scanA(CParams& p, const int wv_s) {
    const unsigned* LB = (const unsigned*)(p.ws + WS_LA); float* TOT = (float*)(p.ws + WS_TOT);
    const long gtid = (long)blockIdx.x * NTHR + tid_fresh(), gth = (long)gridDim.x * NTHR;
    for (long it = gtid; it < (long)NB * 16 * D; it += gth) {
        const int ch = (int)(it & 1023), chunk = (int)(it >> 10) & 15, b = (int)(it >> 14);
        if (chunk == 15) continue;
        const size_t base = ((size_t)b * SEQ + chunk * 128) * D + ch;
        float Ap = 1.f, h = 0.f;
#pragma unroll 16
        for (int t = 0; t < 128; ++t) { float a, bb; unpack_lb(LB[base + (size_t)t * D], a, bb); Ap *= a; h = a * h + bb; }
        TOT[(((size_t)b * 16 + chunk) * D + ch) * 2] = Ap; TOT[(((size_t)b * 16 + chunk) * D + ch) * 2 + 1] = h;
    }
}

__device__ __forceinline__ void ph_scanB(CParams& p, const int wv_s) {
    const unsigned* LB = (const unsigned*)(p.ws + WS_LA); const float* TOT = (const float*)(p.ws + WS_TOT);
    const f16* G1 = (const f16*)(p.ws + WS_G1); f16* U = (f16*)(p.ws + WS_U);
    const long gtid = (long)blockIdx.x * NTHR + tid_fresh(), gth = (long)gridDim.x * NTHR;
    for (long it = gtid; it < (long)NB * 16 * D + DB * D; it += gth) {
        if (it < (long)NB * 16 * D) {
            const int ch = (int)(it & 1023), chunk = (int)(it >> 10) & 15, b = (int)(it >> 14);
            float h = 0.f;
            for (int c2 = 0; c2 < chunk; ++c2) { const f32x2 ab = *(const f32x2*)(TOT + (((size_t)b * 16 + c2) * D + ch) * 2); h = ab[0] * h + ab[1]; }
            const size_t base = ((size_t)b * SEQ + chunk * 128) * D + ch;
#pragma unroll 16
            for (int t = 0; t < 128; ++t) { const size_t o = base + (size_t)t * D; float a, bb; unpack_lb(LB[o], a, bb); h = a * h + bb; U[o] = (f16)(h * (float)G1[o]); }
            if (chunk == 15) p.out[O_HP + (size_t)b * D + ch] = h;
        } else {
            const int i2 = (int)(it - (long)NB * 16 * D); const int ch = i2 & 1023, b = i2 >> 10;
            float h = p.st_h[(size_t)b * D + ch];
            const size_t base = ((size_t)MP + b * 4) * D + ch;
#pragma unroll
            for (int t = 0; t < 4; ++t) { const size_t o = base + (size_t)t * D; float a, bb; unpack_lb(LB[o], a, bb); h = a * h + bb; ((f16*)(p.ws + WS_US))[as16_off(b * 4 + t, ch)] = (f16)(h * (float)G1[o]); }
            p.out[O_HS + (size_t)b * D + ch] = h;
        }
    }
}

template <class ORDER> __device__ __forceinline__ void ph_gates_prep(CParams& p, const ORDER& S, const int wv_s) {
    const int tid = tid_fresh();
    f16* XC = (f16*)(p.ws + WS_XC); const float* XCH = (const float*)(p.ws + WS_XCH); const float* XBT = (const float*)(p.ws + WS_XBT);
    pg::Unit u;
    for (int i = 0; S.next(i, u); ++i) {
        const int pm = u.pm, blk = u.pn >> 1;
        if ((pm & 7) == 0) continue;
        for (int e = tid; e < 768; e += NTHR) {
            const int r = e >> 8, c = blk * 256 + (e & 255);
            const float* t = XBT + (size_t)(pm - 1) * 3 * D + c;
            const float w0 = p.conv_w[c], w1 = p.conv_w[D + c], w2 = p.conv_w[2 * D + c];
            float y = XCH[((size_t)pm * 3 + r) * D + c];
            if (r == 0) y += w2 * t[2 * D] + w1 * t[D] + w0 * t[0]; else if (r == 1) y += w1 * t[2 * D] + w0 * t[D]; else y += w0 * t[2 * D];
            XC[((size_t)pm * 256 + r) * D + c] = (f16)y;
        }
    }
    const f16* XB = (const f16*)(p.ws + WS_XB);
    for (int un = (int)blockIdx.x; un < 64; un += (int)gridDim.x) {
        const int blk = un >> 4;
        for (int it = tid; it < DB * 64; it += NTHR) {
            const int b = it >> 6, c = blk * 256 + (it & 63) * 4;
            const f32x4 w0 = *(const f32x4*)(p.conv_w + c), w1 = *(const f32x4*)(p.conv_w + D + c), w2 = *(const f32x4*)(p.conv_w + 2 * D + c), w3 = *(const f32x4*)(p.conv_w + 3 * D + c);
            const f32x4 bias = *(const f32x4*)(p.conv_b + c);
            const float* st = p.st_conv + (size_t)b * 3 * D + c;
            f32x4 xm3 = *(const f32x4*)st, xm2 = *(const f32x4*)(st + D), xm1 = *(const f32x4*)(st + 2 * D);
#pragma unroll
            for (int t = 0; t < 4; ++t) {
                const int rs = b * 4 + t;
                const f32x4 x0 = ld_h4f(XB + (size_t)(MP + rs) * D + c);
                if (t > 0) *(f32x4*)(p.out + O_CS + ((size_t)b * 3 + (t - 1)) * D + c) = x0;
                const f32x4 y = w3 * x0 + w2 * xm1 + w1 * xm2 + w0 * xm3 + bias;
                *(h4*)(XC + (size_t)(MP + rs) * D + c) = to_h4(y);
                *(h4*)((f16*)(p.ws + WS_XCS) + as16_off(rs, c)) = to_h4(y);
                xm3 = xm2; xm2 = xm1; xm1 = x0;
            }
        }
    }
    asm volatile("s_waitcnt vmcnt(0)" ::: "memory");
    __syncthreads();
}

__device__ __forceinline__ void ph_scan(CParams& p, LAS unsigned char* lds, const int wv_s) {
    const unsigned* LB = (const unsigned*)(p.ws + WS_LA);
    const f16* G1 = (const f16*)(p.ws + WS_G1); f16* U = (f16*)(p.ws + WS_U);
    const int tid = tid_fresh();
    const int chunk = tid >> 3, quad = tid & 7;
    LAS float* AG = (LAS float*)lds;
    LAS float* CR = (LAS float*)(lds + 16384);
    constexpr float KL = 0.015625f * 1.44269504f;
    const int nk = ((NB * 32 - (int)blockIdx.x + (int)gridDim.x - 1) / (int)gridDim.x) * 2;
    auto base_of = [](int k, int chunk, int quad) -> size_t { const int item = (int)blockIdx.x + (k >> 1) * (int)gridDim.x; return ((size_t)(item >> 5) * SEQ + (k & 1) * 1024 + chunk * 16) * D + (item & 31) * 32 + quad * 4; };
    u32x4 lbv[16], nlb[16]; h4 gv[16];
    if (nk > 0) { const unsigned* lbp = LB + base_of(0, chunk, quad);
#pragma unroll
        for (int i = 0; i < 16; ++i) lbv[i] = *(const u32x4*)(lbp + (size_t)i * D); }
    float hc = 0.f;
    for (int k = 0; k < nk; ++k) {
        const size_t base = base_of(k, chunk, quad);
        const f16* gp = G1 + base; f16* up = U + base;
        asm volatile("" : "+v"(gp), "+v"(up));
#pragma unroll
        for (int i = 0; i < 16; ++i) gv[i] = *(const h4*)(gp + (size_t)i * D);
        if (k + 1 < nk) { const unsigned* lbp = LB + base_of(k + 1, chunk, quad);
#pragma unroll
            for (int i = 0; i < 16; ++i) nlb[i] = *(const u32x4*)(lbp + (size_t)i * D); }
        f32x4 ls = {0.f, 0.f, 0.f, 0.f}, h = {0.f, 0.f, 0.f, 0.f};
#pragma unroll
        for (int i = 0; i < 16; ++i)
#pragma unroll
            for (int e = 0; e < 4; ++e) { const unsigned w = lbv[i][e]; const h2v t = __builtin_bit_cast(h2v, w); const float l = (float)t[0]; ls[e] += l; h[e] = __builtin_amdgcn_exp2f(l * KL) * h[e] + (float)t[1]; }
        { LAS f32x4* ag = (LAS f32x4*)(AG + (size_t)tid * 8);
          ag[0] = (f32x4){__builtin_amdgcn_exp2f(ls[0] * KL), h[0], __builtin_amdgcn_exp2f(ls[1] * KL), h[1]};
          ag[1] = (f32x4){__builtin_amdgcn_exp2f(ls[2] * KL), h[2], __builtin_amdgcn_exp2f(ls[3] * KL), h[3]}; }
        __syncthreads();
        if (tid < 32) {
            if ((k & 1) == 0) hc = 0.f;
#pragma unroll
            for (int c = 0; c < 64; ++c) { const f32x2 ah = *(LAS f32x2*)(AG + (c * 32 + tid) * 2); CR[c * 32 + tid] = hc; hc = ah[0] * hc + ah[1]; }
            if (k & 1) { const int item = (int)blockIdx.x + (k >> 1) * (int)gridDim.x; p.out[O_HP + (size_t)(item >> 5) * D + (item & 31) * 32 + tid] = hc; }
        }
        __syncthreads();
        f32x4 hh = *(LAS f32x4*)(CR + (size_t)tid * 4);
#pragma unroll
        for (int i = 0; i < 16; ++i) asm volatile("" : "+v"(lbv[i]));
#pragma unroll
        for (int i = 0; i < 16; ++i) {
            h4 u;
#pragma unroll
            for (int e = 0; e < 4; ++e) { const unsigned w = lbv[i][e]; const h2v t = __builtin_bit_cast(h2v, w); hh[e] = __builtin_amdgcn_exp2f((float)t[0] * KL) * hh[e] + (float)t[1]; u[e] = (f16)(hh[e] * (float)gv[i][e]); }
            *(h4*)(up + (size_t)i * D) = u;
        }
#pragma unroll
        for (int i = 0; i < 16; ++i) lbv[i] = nlb[i];
        __syncthreads();
    }
    const long gtid = (long)blockIdx.x * NTHR + tid, gth = (long)gridDim.x * NTHR;
    for (long it = gtid; it < (long)DB * D; it += gth) {
        const int ch = (int)it & 1023, b = (int)(it >> 10);
        float h = p.st_h[(size_t)b * D + ch];
        const size_t base = ((size_t)MP + b * 4) * D + ch;
#pragma unroll
        for (int t = 0; t < 4; ++t) { const size_t o = base + (size_t)t * D; float a, bb; unpack_lb(LB[o], a, bb); h = a * h + bb; ((f16*)(p.ws + WS_US))[as16_off(b * 4 + t, ch)] = (f16)(h * (float)G1[o]); }
        p.out[O_HS + (size_t)b * D + ch] = h;
    }
}

constexpr int NPHASE = 14;
extern __shared__ __attribute__((aligned(16))) unsigned char dyn_lds[];

#define PHASE_PARAMS() CParams* kp_ = (CParams*)__builtin_amdgcn_kernarg_segment_ptr(); asm volatile("" : "+s"(kp_)); CParams& p = *kp_; \
    float* ADA = (float*)(p.ws + WS_ADA); f16* H = (f16*)(p.ws + WS_H); float* X1 = (float*)(p.ws + WS_X1); (void)ADA; (void)H; (void)X1;
__global__ void __launch_bounds__(NTHR, 2) fwd_kernel(Params p_arg) {
    LAS unsigned char* lds = (LAS unsigned char*)dyn_lds;
    const int wv_s = __builtin_amdgcn_readfirstlane((int)(threadIdx.x >> 6));
#if N_LAUNCH_MODE == 1
    const int lo = 0, hi = NPHASE; (void)p_arg;
    if (threadIdx.x == 0) *(LAS u32x4*)(lds + LDS_BARW) = (u32x4){0u, 0u, 0u, 0u};
    __syncthreads();
    XcdBarrier bar = xcd_barrier_post((unsigned*)(p_arg.ws + WS_CTL), (volatile LAS unsigned*)(lds + LDS_BARW));
#define SEAM(k) do { if ((k) + 1 < hi) xcd_barrier(bar); } while (0)
#else
    const int lo = (int)p_arg.ph_lo, hi = (int)p_arg.ph_hi;
#define SEAM(k) do { } while (0)
#endif
#ifndef PH_MASK
#define PH_MASK 0xFFFF
#endif
#define IN(k) ((((PH_MASK) >> (k)) & 1) && lo <= (k) && (k) < hi)
#ifndef DUP_MASK
#define DUP_MASK 0
#endif
#define DUPQ(k) ((((DUP_MASK) >> (k)) & 1) != 0)

    if (IN(0)) { PHASE_PARAMS(); ph0_prologue(p, lds, wv_s); if (DUPQ(0)) { ph0_prologue(p, lds, wv_s); } SEAM(0); }
    if (IN(1)) { PHASE_PARAMS(); ph_modulate(p.x_p, p.x_s, p.norm_g, ADA, H, (f16*)(p.ws + WS_HS), wv_s);
        {
            f16* SHS = (f16*)(p.ws + WS_SHS); const long gtid = (long)blockIdx.x * NTHR + tid_fresh(), gth = (long)gridDim.x * NTHR;
            for (long e = gtid; e < 128 * D; e += gth) { const int r = (int)(e >> 10), k = (int)(e & 1023); SHS[as16_off(r, k)] = r < 48 ? (f16)ADA[((size_t)48 + r) * 3072 + k] : (f16)0.f; }
        }
        SEAM(1); }
    if (IN(2)) { PHASE_PARAMS();
        const EmitInproj em{(f16*)(p.ws + WS_Q), (f16*)(p.ws + WS_QI), (f16*)(p.ws + WS_SG), (f16*)(p.ws + WS_VT), (float*)(p.ws + WS_WI), p.out};
        {
            const int G = (int)gridDim.x, rem = (MP / 256 * (NIN / 256)) % G, lo = rem == 0 ? 0 : rem;
            thin_gemm(lds, (const f16*)(p.ws + WS_HS), (const f16*)(p.ws + WS_WIN), D, NIN, em, wv_s, lo, G - lo);
            thin_gemm(lds, (const f16*)(p.ws + WS_SHS), (const f16*)(p.ws + WS_WLIN), D, 2 * D, EmitSW{(float*)(p.ws + WS_SW)}, wv_s, lo, G - lo);
        }
        pg::Gemm g{H, (const f16*)(p.ws + WS_WIN), D, D, D};
        pg::GridOrder<MapFull> S; S.init(MP / 256, NIN / 256, (int)gridDim.x, (int)blockIdx.x, MapFull{D, D});
        const EpiMain<EmitInproj> E{em};
        pg::gemm_phase(lds, g, S, E, wv_s); if (DUPQ(2)) { pg::gemm_phase(lds, g, S, E, wv_s); } if (DUPQ(18)) { const EpiMain<EmitNull> EN{EmitNull{}}; pg::gemm_phase(lds, g, S, EN, wv_s); }
        SEAM(2);
    }
    if (IN(3)) { PHASE_PARAMS(); ph3_fixup(p, wv_s); SEAM(3); }
    if (IN(4)) { PHASE_PARAMS(); if (wv_s < 4) { phA_sample(p, lds, wv_s); phA_prompt<true>(p, lds, wv_s); } else { phA_prompt<true>(p, lds, wv_s); phA_sample(p, lds, wv_s); }     if (DUPQ(15)) { phA_sample(p, lds, wv_s); } if (DUPQ(16)) { phA_prompt<true>(p, lds, wv_s); } if (DUPQ(17)) { phA_prompt<false>(p, lds, wv_s); } SEAM(4); }
    if (IN(5)) { PHASE_PARAMS(); phB_sample(p, lds, wv_s); phB_attention(p, lds, wv_s); if (DUPQ(5)) { phB_sample(p, lds, wv_s); } if (DUPQ(14)) { phB_attention(p, lds, wv_s); } SEAM(5); }
    if (IN(6)) { PHASE_PARAMS();
        const float* ADA1 = ADA + (size_t)48 * 3072;
        const EmitResidHS ems{p.x_s, ADA, ADA1, p.norm_g + D, X1 + (size_t)MP * D, (f16*)(p.ws + WS_HS), (float*)(p.ws + WS_SSPS)};
        thin_gemm(lds, (const f16*)(p.ws + WS_AOS), (const f16*)(p.ws + WS_WO0), D, D, ems, wv_s);
        pg::Gemm g{(const f16*)(p.ws + WS_AO), (const f16*)(p.ws + WS_WO0), D, D, D};
        pg::GridOrder<MapFull> S; S.init(MP / 256, D / 256, (int)gridDim.x, (int)blockIdx.x, MapFull{D, D});
        const EpiResidH E{p.x_p, ADA, ADA1, p.norm_g + D, X1, H, (float*)(p.ws + WS_SSP)};
        pg::gemm_phase(lds, g, S, E, wv_s); if (DUPQ(6)) { pg::gemm_phase(lds, g, S, E, wv_s); }
        SEAM(6);
    }
    if (IN(8)) { PHASE_PARAMS();
        const EmitLruIn em{(f16*)(p.ws + WS_XB), (f16*)(p.ws + WS_G1), (const float*)(p.ws + WS_SSPS), (const float*)(p.ws + WS_SW)};
        thin_gemm(lds, (const f16*)(p.ws + WS_HS), (const f16*)(p.ws + WS_WLIN), D, 2 * D, em, wv_s);
        pg::Gemm g{H, (const f16*)(p.ws + WS_WLIN), D, D, D};
        pg::GridOrder<MapFull> S; S.init(MP / 256, 2 * D / 256, (int)gridDim.x, (int)blockIdx.x, MapFull{D, D});
        const EpiLruIn E{em, (f16*)(p.ws + WS_XC), (float*)(p.ws + WS_XCH), (float*)(p.ws + WS_XBT), p.out, p.conv_w, p.conv_b, lds, (const float*)(p.ws + WS_SSP), (const float*)(p.ws + WS_SW)};
        pg::gemm_phase(lds, g, S, E, wv_s); if (DUPQ(8)) { pg::gemm_phase(lds, g, S, E, wv_s); }
        SEAM(8);
    }
    if (IN(10)) { PHASE_PARAMS();
        const EmitGates em{(const f16*)(p.ws + WS_XC), p.b_a, p.b_x, (const float*)(p.ws + WS_LS), (unsigned*)(p.ws + WS_LA)};
        pg::Gemm g{(const f16*)(p.ws + WS_XC), (const f16*)(p.ws + WS_WG), D, 256, 256};
        pg::GridOrder<MapGates> S; S.init(MP / 256, 8, (int)gridDim.x, (int)blockIdx.x, MapGates{});
        ph_gates_prep(p, S, wv_s);
        thin_gemm_gates(lds, (const f16*)(p.ws + WS_XCS), (const f16*)(p.ws + WS_WG), em, wv_s);
        const EpiGates E{em};
        pg::gemm_phase(lds, g, S, E, wv_s); if (DUPQ(10)) { pg::gemm_phase(lds, g, S, E, wv_s); }
        SEAM(10);
    }
    if (IN(11)) { PHASE_PARAMS(); ph_scan(p, lds, wv_s); if (DUPQ(11)) { ph_scan(p, lds, wv_s); } SEAM(11); }
    if (IN(13)) { PHASE_PARAMS();
        const EmitResid em{X1, X1 + (size_t)MP * D, ADA + (size_t)48 * 3072, p.out + O_Y, p.out + O_YS};
        thin_gemm(lds, (const f16*)(p.ws + WS_US), (const f16*)(p.ws + WS_WLO), D, D, em, wv_s);
        pg::Gemm g{(const f16*)(p.ws + WS_U), (const f16*)(p.ws + WS_WLO), D, D, D};
        pg::GridOrder<MapFull> S; S.init(MP / 256, D / 256, (int)gridDim.x, (int)blockIdx.x, MapFull{D, D});
        const EpiMain<EmitResid> E{em};
        pg::gemm_phase(lds, g, S, E, wv_s); if (DUPQ(13)) { pg::gemm_phase(lds, g, S, E, wv_s); }
    }
#undef IN
#undef SEAM
}

extern "C" void kernel_launch(void* const* d_in, const int* in_sizes, int n_in, void* d_out, int out_size, void* d_ws, size_t ws_size, hipStream_t stream) {
    static int grid = 0;
    if (grid == 0) {
        if (n_in != 26 || (size_t)out_size != O_END || ws_size < WS_END) { fprintf(stderr, "kernel_launch: unexpected shapes: n_in %d out %d (want %zu) ws %zu (want %zu)\n", n_in, out_size, (size_t)O_END, ws_size, (size_t)WS_END); grid = -1; return; }
        int dev = 0, cus = 0, per_cu = 0;
        if (hipGetDevice(&dev) != hipSuccess || hipDeviceGetAttribute(&cus, hipDeviceAttributeMultiprocessorCount, dev) != hipSuccess) { grid = -1; return; }
        if (hipFuncSetAttribute((const void*)fwd_kernel, hipFuncAttributeMaxDynamicSharedMemorySize, LDS_BYTES) != hipSuccess) { fprintf(stderr, "kernel_launch: hipFuncSetAttribute failed\n"); grid = -1; return; }
        if (hipOccupancyMaxActiveBlocksPerMultiprocessor(&per_cu, (const void*)fwd_kernel, NTHR, LDS_BYTES) != hipSuccess || per_cu < 1)
            fprintf(stderr, "kernel_launch: occupancy query reports %d blocks per CU\n", per_cu);
        (void)hipGetLastError();
        grid = cus < 256 ? cus : 256;
    }
    if (grid < 0) return;
    (void)hipMemsetAsync((char*)d_ws + WS_CTL, 0, 65536, stream);
    Params p{};
    p.x_p = (const float*)d_in[0]; p.x_s = (const float*)d_in[1]; p.cache_k = (const float*)d_in[2]; p.cache_v = (const float*)d_in[3]; p.cache_ik = (const float*)d_in[4];
    p.st_conv = (const float*)d_in[5]; p.st_h = (const float*)d_in[6]; p.page_table = (const int*)d_in[7]; p.c_p = (const float*)d_in[8]; p.c_s = (const float*)d_in[9];
    p.norm_g = (const float*)d_in[10]; p.ada_w = (const float*)d_in[11]; p.ada_b = (const float*)d_in[12]; p.w_in = (const float*)d_in[13]; p.q_norm = (const float*)d_in[14];
    p.k_norm = (const float*)d_in[15]; p.w_out0 = (const float*)d_in[16]; p.lw_in = (const float*)d_in[17]; p.conv_w = (const float*)d_in[18]; p.conv_b = (const float*)d_in[19];
    p.w_a = (const float*)d_in[20]; p.b_a = (const float*)d_in[21]; p.w_x = (const float*)d_in[22]; p.b_x = (const float*)d_in[23]; p.lam = (const float*)d_in[24]; p.lw_out = (const float*)d_in[25];
    p.out = (float*)d_out; p.ws = (unsigned char*)d_ws;
#if N_LAUNCH_MODE == 1
    p.ph_lo = 0; p.ph_hi = NPHASE;
    hipLaunchKernelGGL(fwd_kernel, dim3(grid), dim3(NTHR), LDS_BYTES, stream, p);
#else
    for (int k = 0; k < NPHASE; ++k) { p.ph_lo = k; p.ph_hi = k + 1; hipLaunchKernelGGL(fwd_kernel, dim3(grid), dim3(NTHR), LDS_BYTES, stream, p); }
#endif
    const hipError_t le = hipPeekAtLastError();
    if (le != hipSuccess) fprintf(stderr, "kernel_launch: launch failed: %s\n", hipGetErrorName(le));
}
```

```cpp
#include <hip/hip_runtime.h>
#include <stdint.h>
#include <stdio.h>

#define DUP_MASK 0
#ifndef N_LAUNCH_MODE
#define N_LAUNCH_MODE 1
#endif

#define LAS __attribute__((address_space(3)))
typedef _Float16 f16;
typedef _Float16 h8 __attribute__((ext_vector_type(8)));
typedef _Float16 h4 __attribute__((ext_vector_type(4)));
typedef float f32x2 __attribute__((ext_vector_type(2)));
typedef float f32x4 __attribute__((ext_vector_type(4)));
typedef float f32x16 __attribute__((ext_vector_type(16)));
typedef unsigned long long u64;
typedef unsigned u32x4 __attribute__((ext_vector_type(4)));

constexpr int D = 1024, NB = 16, SEQ = 2048, MP = NB * SEQ, DB = 32, DT = 4, MS = DB * DT, MT = MP + MS, MPAD = 33024;
constexpr int PAST = 16384, PAGE = 128, NPG = 128, LSP = 16400;
constexpr int NIN = 3840;
constexpr float EPS = 1e-6f;
constexpr int NTHR = 512;

constexpr size_t O_Y = 0, O_YS = O_Y + (size_t)MP * D, O_K = O_YS + (size_t)MS * D, O_V = O_K + (size_t)MP * 256, O_IK = O_V + (size_t)MP * 256,
                 O_KS = O_IK + (size_t)MP * 64, O_VS = O_KS + (size_t)MS * 256, O_IKS = O_VS + (size_t)MS * 256, O_CP = O_IKS + (size_t)MS * 64,
                 O_HP = O_CP + (size_t)NB * 3 * D, O_CS = O_HP + (size_t)NB * D, O_HS = O_CS + (size_t)DB * 3 * D, O_END = O_HS + (size_t)DB * D;

constexpr size_t al256(size_t x) { return (x + 255) & ~(size_t)255; }
constexpr size_t WS_REG = (size_t)MPAD * D * 2;
constexpr size_t WS_CTL = 0, WS_WIN = 65536, WS_WO0 = WS_WIN + al256((size_t)NIN * D * 2), WS_WLIN = WS_WO0 + (size_t)D * D * 2, WS_WG = WS_WLIN + (size_t)2 * D * D * 2,
                 WS_WLO = WS_WG + (size_t)2048 * 256 * 2, WS_ADA = WS_WLO + (size_t)D * D * 2, WS_R0 = WS_ADA + al256((size_t)2 * 48 * 3072 * 4),
                 WS_R1 = WS_R0 + WS_REG, WS_R2 = WS_R1 + WS_REG, WS_R3 = WS_R2 + WS_REG,
                 WS_H = WS_R0, WS_LA = WS_R0, WS_Q = WS_R1, WS_XB = WS_R1, WS_QI = WS_R2, WS_AO = WS_R2, WS_XC = WS_R2, WS_U = WS_R2, WS_SG = WS_R3, WS_G1 = WS_R3,
                 WS_KH = WS_R3 + WS_REG, WS_VT = WS_KH + (size_t)MPAD * 256 * 2, WS_KIH = WS_VT + (size_t)NB * 2 * 128 * SEQ * 2,
                 WS_WI = WS_KIH + (size_t)MPAD * 64 * 2, WS_MASK = WS_WI + (size_t)MPAD * 16 * 4, WS_SCS = WS_MASK + (size_t)MP * 64 * 4,
                 WS_X1 = WS_SCS + al256((size_t)MS * LSP * 4), WS_TOT = WS_X1 + (size_t)MPAD * D * 4,
                 WS_HS = WS_TOT + (size_t)NB * 16 * D * 2 * 4, WS_AOS = WS_HS + 262144, WS_XCS = WS_AOS + 262144, WS_US = WS_XCS + 262144, WS_ROPE = WS_US + 262144, WS_LS = WS_ROPE + al256((size_t)(SEQ + DT) * 24 * 2 * 4), WS_XBT = WS_LS + 4096, WS_SSP = WS_XBT + (size_t)(MP / 256) * 3 * D * 4, WS_SSPS = WS_SSP + (size_t)MP * 16 * 4, WS_SW = WS_SSPS + (size_t)MS * 64 * 4,
                 WS_SHS = WS_SW + (size_t)48 * 2 * D * 4, WS_END = WS_SHS + 262144;
constexpr size_t WS_XCH = WS_TOT;

constexpr int LDS_STAGE = 131072, LDS_AUX = 131072, LDS_BARW = 147456, LDS_BYTES = 147472;

__constant__ double INV32[16] = {1.0, 0.4403666026717805, 0.1939227447486858, 0.08539710028576561, 0.03760603093086394, 0.016560440080994443, 0.007292664737217109,
                                 0.0032114459947525913, 0.0014142135623730955, 0.0006227724219145962, 0.00027424817567620724, 0.00012076973741146502,
                                 5.318295896944988e-05, 2.3419998961409345e-05, 1.0313385377212461e-05, 4.541670480607871e-06};
__constant__ double INV16[8] = {1.0, 0.1939227447486858, 0.03760603093086394, 0.007292664737217109, 0.0014142135623730955, 0.00027424817567620724,
                                5.318295896944988e-05, 1.0313385377212461e-05};

struct Params {
    const float *x_p, *x_s, *cache_k, *cache_v, *cache_ik, *st_conv, *st_h;
    const int* page_table;
    const float *c_p, *c_s, *norm_g, *ada_w, *ada_b, *w_in, *q_norm, *k_norm, *w_out0, *lw_in, *conv_w, *conv_b, *w_a, *b_a, *w_x, *b_x, *lam, *lw_out;
    float* out;
    unsigned char* ws;
    long ph_lo, ph_hi;
};

typedef const Params __attribute__((address_space(4))) CParams;

#define XB_TMO      128
#define XB_XCNT(j)  (256  + 64 * (j))
#define XB_XSUB(j)  (1280 + 64 * (j))
#define XB_XGEN(j)  (2304 + 64 * (j))
#define XB_TOP      3328
#define XB_TOPGEN   3392
#define XCD_BAR_WORDS 3456
#define XB_SPIN_CAP (1u << 22)

__device__ __forceinline__ unsigned xb_ld(unsigned* p)              { return __hip_atomic_load(p, __ATOMIC_RELAXED, __HIP_MEMORY_SCOPE_AGENT); }
__device__ __forceinline__ unsigned xb_add(unsigned* p, unsigned v) { return __hip_atomic_fetch_add(p, v, __ATOMIC_RELAXED, __HIP_MEMORY_SCOPE_AGENT); }
__device__ __forceinline__ unsigned xb_xcc_id() { return (unsigned)__builtin_amdgcn_s_getreg((3 << 11) | 20) & 0xFu; }
#define XB_SPIN(cond, bar) do { unsigned _sp = 0; while (cond) { __builtin_amdgcn_s_sleep(1); \
    if ((++_sp & 255u) == 0u) { if (xb_ld(&(bar)[XB_TMO])) break; if (_sp > XB_SPIN_CAP) { atomicAdd(&(bar)[XB_TMO], 1u); break; } } } } while (0)

struct XcdBarrier { unsigned* bar; unsigned x; volatile LAS unsigned* st; };

__device__ __forceinline__ XcdBarrier xcd_barrier_post(unsigned* bar, volatile LAS unsigned* st) {
    XcdBarrier b; b.bar = bar; b.x = xb_xcc_id(); b.st = st;
    if (threadIdx.x == 0) (void)xb_add(&bar[XB_XCNT(b.x)], 1u);
    return b;
}
__device__ __forceinline__ void xcd_barrier_complete(unsigned* bar, unsigned x, unsigned& nloc, unsigned& nx) {
    const unsigned G = gridDim.x * gridDim.y * gridDim.z;
    unsigned sum, cnt, mine, sp = 0u;
    for (;;) {
        sum = 0u; cnt = 0u; mine = 0u;
#pragma unroll
        for (unsigned j = 0; j < 16; ++j) { const unsigned c = xb_ld(&bar[XB_XCNT(j)]); sum += c; cnt += (c > 0u) ? 1u : 0u; mine = (j == x) ? c : mine; }
        if (sum == G) break;
        __builtin_amdgcn_s_sleep(1);
        if ((++sp & 255u) == 0u) { if (xb_ld(&bar[XB_TMO])) break; if (sp > XB_SPIN_CAP) { atomicAdd(&bar[XB_TMO], 1u); break; } }
    }
    nloc = mine > 0u ? mine : 1u; nx = cnt > 0u ? cnt : 1u;
}
__device__ __forceinline__ void xcd_barrier(const XcdBarrier& b) {
    asm volatile("s_waitcnt vmcnt(0)" ::: "memory");
    __syncthreads();
    if (threadIdx.x == 0) {
        unsigned* bar = b.bar;
        __builtin_amdgcn_s_waitcnt(0);
        unsigned nloc = b.st[0], nx = b.st[1];
        if (nloc == 0u) { xcd_barrier_complete(bar, b.x, nloc, nx); b.st[0] = nloc; b.st[1] = nx; }
        const unsigned old = xb_add(&bar[XB_XSUB(b.x)], 1u);
        const unsigned gen = old / nloc;
        if (old + 1u == (gen + 1u) * nloc) {
            __builtin_amdgcn_fence(__ATOMIC_RELEASE, "agent");
            asm volatile("s_waitcnt vmcnt(0)" ::: "memory");
            const unsigned og = xb_add(&bar[XB_TOP], 1u);
            const unsigned tg = og / nx;
            if (og + 1u == (tg + 1u) * nx) xb_add(&bar[XB_TOPGEN], 1u);
            else XB_SPIN(xb_ld(&bar[XB_TOPGEN]) == tg, bar);
            __builtin_amdgcn_fence(__ATOMIC_ACQUIRE, "agent");
            xb_add(&bar[XB_XGEN(b.x)], 1u);
            asm volatile("s_waitcnt vmcnt(0)" ::: "memory");
        } else {
            XB_SPIN(xb_ld(&bar[XB_XGEN(b.x)]) == gen, bar);
            __builtin_amdgcn_fence(__ATOMIC_ACQUIRE, "agent");
            asm volatile("s_waitcnt vmcnt(0)" ::: "memory");
        }
    }
    __syncthreads();
}

#define WSYNC() asm volatile("s_waitcnt lgkmcnt(0)" ::: "memory")
__device__ __forceinline__ int tid_fresh_(int wv_s) { int l; asm volatile("v_mbcnt_lo_u32_b32 %0, -1, 0\n\tv_mbcnt_hi_u32_b32 %0, -1, %0" : "=v"(l)); return wv_s * 64 + l; }
#define tid_fresh() tid_fresh_(wv_s)
__device__ __forceinline__ float wave_sum(float v) {
#pragma unroll
    for (int o = 32; o > 0; o >>= 1) v += __shfl_xor(v, o);
    return v;
}
__device__ __forceinline__ float wave_max(float v) {
#pragma unroll
    for (int o = 32; o > 0; o >>= 1) v = fmaxf(v, __shfl_xor(v, o));
    return v;
}
__device__ __forceinline__ float wave_min(float v) {
#pragma unroll
    for (int o = 32; o > 0; o >>= 1) v = fminf(v, __shfl_xor(v, o));
    return v;
}
__device__ __forceinline__ float relu_f(float x) { const int b = __builtin_bit_cast(int, x); return __builtin_bit_cast(float, b > 0 ? b : 0); }
__device__ __forceinline__ float silu_f(float v) { return v * __builtin_amdgcn_rcpf(1.f + __expf(-v)); }
__device__ __forceinline__ float sigmoid_f(float v) { return __builtin_amdgcn_rcpf(1.f + __expf(-v)); }
__device__ __forceinline__ h4 to_h4(f32x4 v) { h4 r; r[0] = (f16)v[0]; r[1] = (f16)v[1]; r[2] = (f16)v[2]; r[3] = (f16)v[3]; return r; }
typedef _Float16 h2v __attribute__((ext_vector_type(2)));
__device__ __forceinline__ unsigned pack_lb(float l, float b) { h2v t; t[0] = (f16)(l * 64.f); t[1] = (f16)b; return __builtin_bit_cast(unsigned, t); }
__device__ __forceinline__ void unpack_lb(unsigned w, float& a, float& b) { const h2v t = __builtin_bit_cast(h2v, w); a = __expf((float)t[0] * 0.015625f); b = (float)t[1]; }
__device__ __forceinline__ void rope_cs(int pos, double inv, float& c, float& sn) { double rev = (double)pos * inv * 0.15915494309189535; rev -= floor(rev); const float rf = (float)rev; c = __builtin_amdgcn_cosf(rf); sn = __builtin_amdgcn_sinf(rf); }
__device__ __forceinline__ const float* rope_row(const float* ROPE, int pos, int f0) { const int idx = pos < SEQ ? pos : SEQ + (pos - PAST); return ROPE + ((size_t)idx * 24 + f0) * 2; }
__device__ __forceinline__ int row_pos(int row) { return row < MP ? (row & (SEQ - 1)) : PAST + ((row - MP) & 3); }
__device__ __forceinline__ int row_arow(int row) { return row < MP ? (row >> 11) : 16 + ((row - MP) >> 2); }

namespace pg {
constexpr int BM = 256, BK = 64, HALF = 128, HTB = HALF * BK * 2, STAGE_BYTES = 8 * HTB, NXCD = 8, WGM = 8;
__host__ __device__ __forceinline__ int lds_byte(int r, int c) { const int st = (r >> 4) * 2 + (c >> 5), rr = r & 15, cc = c & 31, ob = rr * 64 + cc * 2; return st * 1024 + (ob ^ (((ob >> 9) & 1) << 5)); }
__host__ __device__ __forceinline__ void stage_rc(int b, int& R, int& C) { const int st = b / 1024, sb = b % 1024, swz = sb ^ (((sb >> 9) & 1) << 5); R = (st >> 1) * 16 + swz / 64; C = (st & 1) * 32 + (swz % 64) / 2; }

__host__ __device__ __forceinline__ int perm32(int rho) { const int n = rho >> 4, i = rho & 15; return 8 * (i >> 2) + 4 * n + (i & 3); }
struct Unit { int pm, pn; long aoff, boff; };
struct Gemm { const f16* A; const f16* Bt; int lda, ldb, K; };

template <class MAP> struct GridOrder {
    int nM, nN, nwg, G, c; MAP map;
    __device__ void init(int nM_, int nN_, int G_, int c_, MAP m) { nM = nM_; nN = nN_; nwg = nM * nN; G = G_; c = c_; map = m; }
    __device__ bool next(int i, Unit& u) const {
        const long L = (long)i * G + c; if (L >= nwg) return false;
        int wgid = (int)L; { const int q = nwg / NXCD, r = nwg % NXCD, xcd = wgid % NXCD, off = wgid / NXCD; wgid = (xcd < r ? xcd * (q + 1) : r * (q + 1) + (xcd - r) * q) + off; }
        const int nig = WGM * nN, gid = wgid / nig, fm = gid * WGM, gsz = (nM - fm) < WGM ? (nM - fm) : WGM;
        u.pm = fm + ((wgid % nig) % gsz); u.pn = (wgid % nig) / gsz; map(u); return true;
    }
};

template <class Epi, class Sched>
__device__ __forceinline__ void gemm_phase(LAS unsigned char* lds, const Gemm g, const Sched& S, const Epi& E, const int wv_s) {
    const int tid = tid_fresh(), wid = __builtin_amdgcn_readfirstlane(tid >> 6), lane = tid & 63, wr = wid >> 2, wc = wid & 3, fr = lane & 15, fq = lane >> 4;
    const int K = g.K, nt = K / BK;
    unsigned voffA[2], voffB[2];
#pragma unroll
    for (int i = 0; i < 2; ++i) { int R, C; stage_rc(tid * 16 + i * 8192, R, C); const int Rb = (R & ~31) + perm32(R & 31);
        voffA[i] = (unsigned)(R * g.lda + C) * 2u; voffB[i] = (unsigned)(Rb * g.ldb + C) * 2u; }
    const size_t kstep = (size_t)(BK * 2);
    const size_t hstepA = (size_t)HALF * g.lda * 2, hstepB = (size_t)HALF * g.ldb * 2;
    const unsigned ldsw = (unsigned)wid * 1024u;
    const int aoff = lds_byte(wr * 64 + fr, fq * 8), boff = lds_byte(wc * 32 + fr, fq * 8);
#define PG_SA(b, h) (((b) * 2 + (h)) * HTB)
#define PG_SB(b, h) ((4 + (b) * 2 + (h)) * HTB)
#define PG_STAGE(bufoff, gbase, voff) do { _Pragma("unroll") for (int _i = 0; _i < 2; ++_i) \
        __builtin_amdgcn_global_load_lds((const unsigned*)((const char*)(gbase) + (voff)[_i]), (LAS unsigned*)(lds + (bufoff) + ldsw + _i * 8192), 16, 0, 0); } while (0)
#define PG_LDA(dst, b, h) do { _Pragma("unroll") for (int m = 0; m < 4; ++m) _Pragma("unroll") for (int k = 0; k < 2; ++k) dst[m][k] = *(const LAS h8*)(lds + PG_SA(b, h) + aoff + m * 2048 + k * 1024); } while (0)
#define PG_LDB(dst, b, h) do { _Pragma("unroll") for (int n = 0; n < 2; ++n) _Pragma("unroll") for (int k = 0; k < 2; ++k) dst[n][k] = *(const LAS h8*)(lds + PG_SB(b, h) + boff + n * 2048 + k * 1024); } while (0)
#define PG_MMA(ai, bj, At, Bt) do { __builtin_amdgcn_s_setprio(1); _Pragma("unroll") for (int m = 0; m < 4; ++m) _Pragma("unroll") for (int n = 0; n < 2; ++n) _Pragma("unroll") for (int k = 0; k < 2; ++k) \
        acc[ai][bj][m][n] = __builtin_amdgcn_mfma_f32_16x16x32_f16(Bt[n][k], At[m][k], acc[ai][bj][m][n], 0, 0, 0); __builtin_amdgcn_s_setprio(0); } while (0)
#define PG_WAIT_V(n) asm volatile("s_waitcnt vmcnt(" #n ")" ::: "memory")
#define PG_WAIT_L(n) asm volatile("s_waitcnt lgkmcnt(" #n ")" ::: "memory")
#define PG_BAR __builtin_amdgcn_s_barrier()
#define PG_SCHED __builtin_amdgcn_sched_barrier(0)
    Unit cur, nxt; int ui = 0;
    if (!S.next(0, cur)) return;
    f32x4 acc[2][2][4][2];
#pragma unroll
    for (int a = 0; a < 2; ++a)
#pragma unroll
        for (int b = 0; b < 2; ++b)
#pragma unroll
            for (int m = 0; m < 4; ++m)
#pragma unroll
                for (int n = 0; n < 2; ++n) acc[a][b][m][n] = (f32x4){0.f, 0.f, 0.f, 0.f};
    h8 At[4][2], B0[2][2], B1[2][2];
    const char* cA = (const char*)g.A + (size_t)cur.aoff * 2; const char* cB = (const char*)g.Bt + (size_t)cur.boff * 2;
    PG_STAGE(PG_SB(0, 0), cB, voffB); PG_STAGE(PG_SA(0, 0), cA, voffA); PG_STAGE(PG_SB(0, 1), cB + hstepB, voffB); PG_STAGE(PG_SA(0, 1), cA + hstepA, voffA);
    if (wr == 1) PG_BAR;
    PG_WAIT_V(4); PG_BAR;
    PG_STAGE(PG_SB(1, 0), cB + kstep, voffB); PG_STAGE(PG_SA(1, 0), cA + kstep, voffA); PG_STAGE(PG_SB(1, 1), cB + hstepB + kstep, voffB);
    PG_WAIT_V(6); PG_BAR;
    for (;;) {
        const bool has_next = S.next(ui + 1, nxt);
        const char* nA = has_next ? (const char*)g.A + (size_t)nxt.aoff * 2 : cA; const char* nB = has_next ? (const char*)g.Bt + (size_t)nxt.boff * 2 : cB;
#pragma nounroll
        for (int t = 0; t < nt; t += 2) {
            const bool last = (t == nt - 2);
            const char* a1 = cA + (size_t)(t + 1) * kstep;
            const char* a2 = last ? nA : cA + (size_t)(t + 2) * kstep; const char* b2 = last ? nB : cB + (size_t)(t + 2) * kstep;
            const char* a3 = a2 + kstep; const char* b3 = b2 + kstep;
            PG_LDB(B0, 0, 0); PG_SCHED; PG_LDA(At, 0, 0); PG_STAGE(PG_SA(1, 1), a1 + hstepA, voffA);
            PG_WAIT_L(8); PG_BAR; PG_WAIT_L(0); PG_MMA(0, 0, At, B0); PG_BAR; PG_SCHED;
            PG_LDB(B1, 0, 1); PG_STAGE(PG_SB(0, 0), b2, voffB);
            PG_BAR; PG_WAIT_L(0); PG_MMA(0, 1, At, B1); PG_BAR;
            PG_LDA(At, 0, 1); PG_STAGE(PG_SA(0, 0), a2, voffA);
            PG_BAR; PG_WAIT_L(0); PG_MMA(1, 0, At, B0); PG_BAR; PG_SCHED;
            PG_STAGE(PG_SB(0, 1), b2 + hstepB, voffB);
            PG_WAIT_V(6); PG_BAR; PG_MMA(1, 1, At, B1); PG_BAR;
            PG_LDB(B0, 1, 0); PG_SCHED; PG_LDA(At, 1, 0); PG_STAGE(PG_SA(0, 1), a2 + hstepA, voffA);
            PG_WAIT_L(8); PG_BAR; PG_WAIT_L(0); PG_MMA(0, 0, At, B0); PG_BAR; PG_SCHED;
            PG_LDB(B1, 1, 1); PG_STAGE(PG_SB(1, 0), b3, voffB);
            PG_BAR; PG_WAIT_L(0); PG_MMA(0, 1, At, B1); PG_BAR;
            PG_LDA(At, 1, 1); PG_STAGE(PG_SA(1, 0), a3, voffA);
            PG_BAR; PG_WAIT_L(0); PG_MMA(1, 0, At, B0); PG_BAR; PG_SCHED;
            PG_STAGE(PG_SB(1, 1), b3 + hstepB, voffB);
            PG_WAIT_V(6); PG_BAR; PG_MMA(1, 1, At, B1); PG_BAR;
        }
        E(acc, cur, wr, wc, fr, fq);
        if (!has_next) break;
#pragma unroll
        for (int a = 0; a < 2; ++a)
#pragma unroll
            for (int b = 0; b < 2; ++b)
#pragma unroll
                for (int m = 0; m < 4; ++m)
#pragma unroll
                    for (int n = 0; n < 2; ++n) acc[a][b][m][n] = (f32x4){0.f, 0.f, 0.f, 0.f};
        cur = nxt; cA = nA; cB = nB; ++ui;
    }
    PG_WAIT_V(0);
    if (wr == 0) PG_BAR;
    PG_BAR;
#undef PG_SA
#undef PG_SB
#undef PG_STAGE
#undef PG_LDA
#undef PG_LDB
#undef PG_MMA
#undef PG_WAIT_V
#undef PG_WAIT_L
#undef PG_BAR
#undef PG_SCHED
}
}

struct MapFull { int lda, ldb; __device__ void operator()(pg::Unit& u) const { u.aoff = (long)u.pm * 256 * lda; u.boff = (long)u.pn * 256 * ldb; } };
struct MapGates { __device__ void operator()(pg::Unit& u) const { u.aoff = (long)u.pm * 256 * D + (u.pn >> 1) * 256; u.boff = (long)u.pn * 256 * 256; } };

__device__ __forceinline__ size_t as16_off(int rs, int k) { return ((size_t)(((k >> 5) * 8 + (rs >> 4)) * 64 + ((k >> 3) & 3) * 16 + (rs & 15))) * 8 + (k & 7); }

__device__ __forceinline__ h8 to_h8(f32x4 a, f32x4 b) { h8 r; r[0] = (f16)a[0]; r[1] = (f16)a[1]; r[2] = (f16)a[2]; r[3] = (f16)a[3]; r[4] = (f16)b[0]; r[5] = (f16)b[1]; r[6] = (f16)b[2]; r[7] = (f16)b[3]; return r; }
__device__ __forceinline__ f32x4 silu4(f32x4 v) { f32x4 s; s[0] = silu_f(v[0]); s[1] = silu_f(v[1]); s[2] = silu_f(v[2]); s[3] = silu_f(v[3]); return s; }
template <class Emit> struct EpiMain {
    Emit em;
    __device__ __forceinline__ void operator()(const f32x4 (&acc)[2][2][4][2], const pg::Unit& u, int wr, int wc, int fr, int fq) const {
        const int pn = __builtin_amdgcn_readfirstlane(u.pn);
#pragma unroll
        for (int ai = 0; ai < 2; ++ai)
#pragma unroll
            for (int m = 0; m < 4; ++m) {
                const int row = u.pm * 256 + ai * 128 + wr * 64 + m * 16 + fr;
#pragma unroll
                for (int bj = 0; bj < 2; ++bj) em.template emit8<false>(pn, row, u.pn * 256 + bj * 128 + wc * 32 + 8 * fq, acc[ai][bj][m][0], acc[ai][bj][m][1]);
            }
    }
};

struct EmitNull { template <bool SMP> __device__ __forceinline__ void emit8(int pn, int row, int col, const f32x4 v, const f32x4 w) const { if (v[0] == 1.2345e30f && w[0] == 1.f) *(volatile int*)nullptr = row + col; } };
struct EmitInproj {
    f16 *Q, *QI, *SG, *VT; float* WI; float* out;
    template <bool SMP> __device__ __forceinline__ void emit(int pn, int row, int col, const f32x4 v) const {
        constexpr bool smp = SMP; const int rs = row - MP;
        if (pn < 4) { *(h4*)(Q + (size_t)row * D + col) = to_h4(v); }
        else if (pn == 4) { float* dst = smp ? out + O_KS + (size_t)rs * 256 + (col - 1024) : out + O_K + (size_t)row * 256 + (col - 1024); *(f32x4*)dst = v; }
        else if (pn == 5) {
            const int c5 = col - 1280;
            float* dst = smp ? out + O_VS + (size_t)rs * 256 + c5 : out + O_V + (size_t)row * 256 + c5; *(f32x4*)dst = v;
            if (!smp) { const int b = row >> 11, pos = row & (SEQ - 1), kvh = c5 >> 7, d = c5 & 127;
                const int pk = pos & 15, pp = (pos & ~15) | (pk < 4 ? pk : (pk < 8 ? pk + 4 : (pk < 12 ? pk - 4 : pk)));
                f16* vt = VT + ((size_t)(b * 2 + kvh) * 128 + d) * SEQ + pp;
                vt[0] = (f16)v[0]; vt[SEQ] = (f16)v[1]; vt[2 * SEQ] = (f16)v[2]; vt[3 * SEQ] = (f16)v[3]; }
        }
        else if (pn < 10) { *(h4*)(QI + (size_t)row * D + (col - 1536)) = to_h4(v); }
        else if (pn < 14) { *(h4*)(SG + (size_t)row * D + (col - 2560)) = to_h4(v); }
        else { const int c14 = col - 3584;
            if (c14 < 64) { float* dst = smp ? out + O_IKS + (size_t)rs * 64 + c14 : out + O_IK + (size_t)row * 64 + c14; *(f32x4*)dst = v; }
            else if (c14 < 80) { *(f32x4*)(WI + (size_t)row * 16 + (c14 - 64)) = v * 0.03125f; } }
    }
    template <bool SMP> __device__ __forceinline__ void emit8(int pn, int row, int col, const f32x4 v, const f32x4 w) const {
        if (pn < 4) { *(h8*)(Q + (size_t)row * D + col) = to_h8(v, w); }
        else if (pn >= 6 && pn < 10) { *(h8*)(QI + (size_t)row * D + (col - 1536)) = to_h8(v, w); }
        else if (pn >= 10 && pn < 14) { *(h8*)(SG + (size_t)row * D + (col - 2560)) = to_h8(v, w); }
        else { emit<SMP>(pn, row, col, v); emit<SMP>(pn, row, col + 4, w); }
    }
};

struct EmitResid {
    const float *xa, *xb; const float* gate; float *oa, *ob;
    template <bool SMP> __device__ __forceinline__ void emit(int pn, int row, int col, const f32x4 v) const {
        constexpr bool smp = SMP; const int rs = row - MP;
        const f32x4 gv = *(const f32x4*)(gate + (size_t)row_arow(row) * 3072 + 2048 + col);
        const f32x4 xv = smp ? *(const f32x4*)(xb + (size_t)rs * D + col) : *(const f32x4*)(xa + (size_t)row * D + col);
        float* dst = smp ? ob + (size_t)rs * D + col : oa + (size_t)row * D + col;
        *(f32x4*)dst = xv + gv * v;
    }
    template <bool SMP> __device__ __forceinline__ void emit8(int pn, int row, int col, const f32x4 v, const f32x4 w) const { emit<SMP>(pn, row, col, v); emit<SMP>(pn, row, col + 4, w); }
};

struct EpiResidH {
    const float* x; const float *ada0, *ada1, *ng1; float* X1; f16* Hn; float* SSP;
    __device__ __forceinline__ void operator()(const f32x4 (&acc)[2][2][4][2], const pg::Unit& u, int wr, int wc, int fr, int fq) const {
        const int pn = __builtin_amdgcn_readfirstlane(u.pn), pm = __builtin_amdgcn_readfirstlane(u.pm);
        const float *a0 = ada0 + (size_t)(pm >> 3) * 3072 + 2048, *a1 = ada1 + (size_t)(pm >> 3) * 3072 + 1024;
        f32x4 gt[2][2], ff[2][2];
#pragma unroll
        for (int bj = 0; bj < 2; ++bj)
#pragma unroll
            for (int n = 0; n < 2; ++n) { const int c = pn * 256 + bj * 128 + wc * 32 + 8 * fq + 4 * n;
                gt[bj][n] = *(const f32x4*)(a0 + c); ff[bj][n] = *(const f32x4*)(ng1 + c) * (*(const f32x4*)(a1 + c) + 1.f); }
        f32x4 xq[2][2][2];
#define RH_LOAD(AI, M) { const float* xr_ = x + (size_t)(pm * 256 + (AI) * 128 + wr * 64 + (M) * 16 + fr) * D + pn * 256 + wc * 32 + 8 * fq; \
        _Pragma("unroll") for (int bj = 0; bj < 2; ++bj) { xq[(M) & 1][bj][0] = *(const f32x4*)(xr_ + bj * 128); xq[(M) & 1][bj][1] = *(const f32x4*)(xr_ + bj * 128 + 4); } }
#define RH_ROW(AI, M) { const int row = pm * 256 + (AI) * 128 + wr * 64 + (M) * 16 + fr; float ss = 0.f; \
        _Pragma("unroll") for (int bj = 0; bj < 2; ++bj) { const int c = pn * 256 + bj * 128 + wc * 32 + 8 * fq; \
            const f32x4 y0 = xq[(M) & 1][bj][0] + gt[bj][0] * acc[AI][bj][M][0], y1 = xq[(M) & 1][bj][1] + gt[bj][1] * acc[AI][bj][M][1]; \
            float* d = X1 + (size_t)row * D + c; *(f32x4*)d = y0; *(f32x4*)(d + 4) = y1; \
            *(h8*)(Hn + (size_t)row * D + c) = to_h8(y0 * ff[bj][0], y1 * ff[bj][1]); \
            ss += y0[0] * y0[0] + y0[1] * y0[1] + y0[2] * y0[2] + y0[3] * y0[3] + y1[0] * y1[0] + y1[1] * y1[1] + y1[2] * y1[2] + y1[3] * y1[3]; } \
        ss += __shfl_xor(ss, 16); ss += __shfl_xor(ss, 32); \
        if (fq == 0) SSP[(size_t)row * 16 + pn * 4 + wc] = ss; }
        RH_LOAD(0, 0) RH_LOAD(0, 1)
        RH_ROW(0, 0) RH_LOAD(0, 2)
        RH_ROW(0, 1) RH_LOAD(0, 3)
        RH_ROW(0, 2) RH_LOAD(1, 0)
        RH_ROW(0, 3) RH_LOAD(1, 1)
        RH_ROW(1, 0) RH_LOAD(1, 2)
        RH_ROW(1, 1) RH_LOAD(1, 3)
        RH_ROW(1, 2) RH_ROW(1, 3)
#undef RH_LOAD
#undef RH_ROW
    }
};
struct EpiResidOut {
    const float* x1; const float* ada1; float* y;
    __device__ __forceinline__ void operator()(const f32x4 (&acc)[2][2][4][2], const pg::Unit& u, int wr, int wc, int fr, int fq) const {
        const int pn = __builtin_amdgcn_readfirstlane(u.pn), pm = __builtin_amdgcn_readfirstlane(u.pm);
        const float* a1 = ada1 + (size_t)(pm >> 3) * 3072 + 2048;
        f32x4 gt[2][2];
#pragma unroll
        for (int bj = 0; bj < 2; ++bj)
#pragma unroll
            for (int n = 0; n < 2; ++n) gt[bj][n] = *(const f32x4*)(a1 + pn * 256 + bj * 128 + wc * 32 + 8 * fq + 4 * n);
        f32x4 xq[4][2][2];
#define RO_LOAD(AI, M) { const float* xr_ = x1 + (size_t)(pm * 256 + (AI) * 128 + wr * 64 + (M) * 16 + fr) * D + pn * 256 + wc * 32 + 8 * fq; \
        _Pragma("unroll") for (int bj = 0; bj < 2; ++bj) { xq[M][bj][0] = *(const f32x4*)(xr_ + bj * 128); xq[M][bj][1] = *(const f32x4*)(xr_ + bj * 128 + 4); } }
#define RO_ROW(AI, M) { float* yr_ = y + (size_t)(pm * 256 + (AI) * 128 + wr * 64 + (M) * 16 + fr) * D + pn * 256 + wc * 32 + 8 * fq; \
        _Pragma("unroll") for (int bj = 0; bj < 2; ++bj) { *(f32x4*)(yr_ + bj * 128) = xq[M][bj][0] + gt[bj][0] * acc[AI][bj][M][0]; *(f32x4*)(yr_ + bj * 128 + 4) = xq[M][bj][1] + gt[bj][1] * acc[AI][bj][M][1]; } }
        RO_LOAD(0, 0) RO_LOAD(0, 1) RO_LOAD(0, 2) RO_LOAD(0, 3)
        RO_ROW(0, 0) RO_LOAD(1, 0)
        RO_ROW(0, 1) RO_LOAD(1, 1)
        RO_ROW(0, 2) RO_LOAD(1, 2)
        RO_ROW(0, 3) RO_LOAD(1, 3)
        RO_ROW(1, 0) RO_ROW(1, 1) RO_ROW(1, 2) RO_ROW(1, 3)
#undef RO_LOAD
#undef RO_ROW
    }
};
struct EmitResidHS {
    const float* xs; const float *ada0, *ada1, *ng1; float* X1s; f16* HS; float* SSPS;
    template <bool SMP> __device__ __forceinline__ void emit(int pn, int row, int col, const f32x4 v) const {
        const int rs = row - MP, ar = 16 + (rs >> 2);
        const f32x4 y = *(const f32x4*)(xs + (size_t)rs * D + col) + *(const f32x4*)(ada0 + (size_t)ar * 3072 + 2048 + col) * v;
        *(f32x4*)(X1s + (size_t)rs * D + col) = y;
        const f32x4 f = *(const f32x4*)(ng1 + col) * (*(const f32x4*)(ada1 + (size_t)ar * 3072 + 1024 + col) + 1.f);
        *(h4*)(HS + as16_off(rs, col)) = to_h4(y * f);
        float ss = y[0] * y[0] + y[1] * y[1] + y[2] * y[2] + y[3] * y[3];
        ss += __shfl_xor(ss, 16); ss += __shfl_xor(ss, 32);
        if ((col & 15) == 0) SSPS[(size_t)rs * 64 + (col >> 4)] = ss;
    }
};
struct EmitSW {
    float* SW;
    template <bool SMP> __device__ __forceinline__ void emit(int pn, int row, int col, const f32x4 v) const { const int rs = row - MP; if (rs < 48) *(f32x4*)(SW + (size_t)rs * 2 * D + col) = v; }
};

struct EmitLruIn {
    f16* XB; f16* G1; const float *SSPS, *SW;
    template <bool SMP> __device__ __forceinline__ void emit(int pn, int row, int col, const f32x4 v0) const {
        const int rs = row - MP;
        f32x4 t = (f32x4){0.f, 0.f, 0.f, 0.f};
#pragma unroll
        for (int i = 0; i < 16; ++i) t += *(const f32x4*)(SSPS + (size_t)rs * 64 + 4 * i);
        const float rstd = rsqrtf(((t[0] + t[1]) + (t[2] + t[3])) * (1.f / D) + EPS);
        const f32x4 v = v0 * rstd + *(const f32x4*)(SW + (size_t)(16 + (rs >> 2)) * 2 * D + col);
        if (pn < 4) { *(h4*)(XB + (size_t)row * D + col) = to_h4(v); }
        else { *(h4*)(G1 + (size_t)row * D + (col - 1024)) = to_h4(silu4(v)); }
    }
    template <bool SMP> __device__ __forceinline__ void emit8(int pn, int row, int col, const f32x4 v, const f32x4 w) const {
        if (pn < 4) { *(h8*)(XB + (size_t)row * D + col) = to_h8(v, w); }
        else { *(h8*)(G1 + (size_t)row * D + (col - 1024)) = to_h8(silu4(v), silu4(w)); }
    }
};

#define DPP_ROW_ROR(n) (0x120 + (n))
#define dpp_ror_f(src, n) __int_as_float(__builtin_amdgcn_update_dpp(__float_as_int(src), __float_as_int(src), DPP_ROW_ROR(n), 0xf, 0xf, false))
struct EpiLruIn {
    EmitLruIn em; f16* XC; float* XCH; float* XBT; float* out; const float *cw, *cb; LAS unsigned char* lds; const float *SSP, *SW;
    __device__ __forceinline__ void operator()(f32x4 (&acc)[2][2][4][2], const pg::Unit& u, int wr, int wc, int fr, int fq) const {
        const int pn = __builtin_amdgcn_readfirstlane(u.pn), pm = __builtin_amdgcn_readfirstlane(u.pm);
        {
            f32x4 sw[2][2];
#pragma unroll
            for (int bj = 0; bj < 2; ++bj)
#pragma unroll
                for (int n = 0; n < 2; ++n) sw[bj][n] = *(const f32x4*)(SW + (size_t)(pm >> 3) * 2 * D + pn * 256 + bj * 128 + wc * 32 + 8 * fq + 4 * n);
            f32x4 sp[2][4];
#pragma unroll
            for (int ai = 0; ai < 2; ++ai)
#pragma unroll
                for (int m = 0; m < 4; ++m) sp[ai][m] = *(const f32x4*)(SSP + (size_t)(pm * 256 + ai * 128 + wr * 64 + m * 16 + fr) * 16 + 4 * fq);
#pragma unroll
            for (int ai = 0; ai < 2; ++ai)
#pragma unroll
                for (int m = 0; m < 4; ++m) {
                    float ssum = (sp[ai][m][0] + sp[ai][m][1]) + (sp[ai][m][2] + sp[ai][m][3]);
                    ssum += __shfl_xor(ssum, 16); ssum += __shfl_xor(ssum, 32);
                    const float rstd = rsqrtf(ssum * (1.f / D) + EPS);
#pragma unroll
                    for (int bj = 0; bj < 2; ++bj)
#pragma unroll
                        for (int n = 0; n < 2; ++n) acc[ai][bj][m][n] = acc[ai][bj][m][n] * rstd + sw[bj][n];
                }
        }
        if (pn >= 4) {
#pragma unroll
            for (int ai = 0; ai < 2; ++ai)
#pragma unroll
                for (int m = 0; m < 4; ++m) {
                    const int row = pm * 256 + ai * 128 + wr * 64 + m * 16 + fr;
#pragma unroll
                    for (int bj = 0; bj < 2; ++bj) em.template emit8<false>(pn, row, pn * 256 + bj * 128 + wc * 32 + 8 * fq, acc[ai][bj][m][0], acc[ai][bj][m][1]);
                }
            return;
        }
        LAS float* T = (LAS float*)(lds + LDS_AUX);
        const int lc = wc * 32 + 8 * fq;
        if (fr >= 13) {
#pragma unroll
            for (int ai = 0; ai < 2; ++ai)
#pragma unroll
                for (int bj = 0; bj < 2; ++bj)
#pragma unroll
                    for (int n = 0; n < 2; ++n) *(LAS f32x4*)(T + ((2 * ai + wr) * 3 + (fr - 13)) * 256 + 128 * bj + lc + 4 * n) = acc[ai][bj][3][n];
        }
        asm volatile("s_waitcnt lgkmcnt(0)" ::: "memory");
        __builtin_amdgcn_s_barrier(); __builtin_amdgcn_s_barrier();
        asm volatile("" ::: "memory");
#pragma unroll
        for (int bj = 0; bj < 2; ++bj)
#pragma unroll
        for (int n = 0; n < 2; ++n) {
            const int gc = pn * 256 + 128 * bj + lc + 4 * n, tc = 128 * bj + lc + 4 * n;
            const f32x4 w0 = *(const f32x4*)(cw + gc), w1 = *(const f32x4*)(cw + D + gc), w2 = *(const f32x4*)(cw + 2 * D + gc), w3 = *(const f32x4*)(cw + 3 * D + gc), bs = *(const f32x4*)(cb + gc);
#pragma unroll
            for (int ai = 0; ai < 2; ++ai) {
                const int slab = 2 * ai + wr;
                f32x4 prev = (f32x4){0.f, 0.f, 0.f, 0.f};
                if (slab > 0 && fr >= 13) prev = *(const LAS f32x4*)(T + ((slab - 1) * 3 + (fr - 13)) * 256 + tc);
#pragma unroll
                for (int m = 0; m < 4; ++m) {
                    const f32x4 xv = acc[ai][bj][m][n];
                    f32x4 y;
#pragma unroll
                    for (int e = 0; e < 4; ++e) {
                        const float X = xv[e], P = prev[e];
                        const float s1 = fr >= 15 ? P : X, s2 = fr >= 14 ? P : X, s3 = fr >= 13 ? P : X;
                        y[e] = bs[e] + w3[e] * X + w2[e] * dpp_ror_f(s1, 1) + w1[e] * dpp_ror_f(s2, 2) + w0[e] * dpp_ror_f(s3, 3);
                    }
                    const int row = pm * 256 + ai * 128 + wr * 64 + m * 16 + fr;
                    *(h4*)(XC + (size_t)row * D + gc) = to_h4(y);
                    if (slab == 0 && m == 0 && fr < 3) *(f32x4*)(XCH + ((size_t)pm * 3 + fr) * D + gc) = y;
                    if (slab == 3 && m == 3 && fr >= 13) {
                        *(f32x4*)(XBT + ((size_t)pm * 3 + (fr - 13)) * D + gc) = xv;
                        if ((pm & 7) == 7) *(f32x4*)(out + O_CP + ((size_t)(pm >> 3) * 3 + (fr - 13)) * D + gc) = xv;
                    }
                    prev = xv;
                }
            }
        }
    }
};

struct GateCols { f32x4 ba, bx, ls; };
struct EmitGates {
    const f16* XC; const float *b_a, *b_x, *lam; unsigned* LB;
    __device__ __forceinline__ GateCols cols(int ch) const {
        GateCols g; g.ba = *(const f32x4*)(b_a + ch) * -1.44269504f; g.bx = *(const f32x4*)(b_x + ch) * -1.44269504f; g.ls = *(const f32x4*)(lam + ch);
        return g; }
    __device__ __forceinline__ unsigned elem(float rp, float ip, float ba, float bx, float ls, float xc) const {
        const float er = __builtin_amdgcn_exp2f(__builtin_fmaf(rp, -1.44269504f, ba)), ei = __builtin_amdgcn_exp2f(__builtin_fmaf(ip, -1.44269504f, bx));
        const float l = ls * __builtin_amdgcn_rcpf(1.f + er);
        const float x2 = 2.f * l;
        const float ser = -x2 * (1.f + x2 * (0.5f + x2 * 0.16666667f));
        const float dir = 1.f - __builtin_amdgcn_exp2f(2.88539008f * l);
        const float om0 = (x2 > -0.03125f) ? ser : dir;
        const int ob = __builtin_bit_cast(int, om0), fl = __builtin_bit_cast(int, 1e-30f);
        const float om = __builtin_bit_cast(float, ob > fl ? ob : fl);
        const float t = 1.f + ei;
        return pack_lb(l, om * __builtin_amdgcn_rsqf(om * t * t) * xc);
    }
    __device__ __forceinline__ void emit2(int row, int ch, const GateCols& g, const f32x4 rp, const f32x4 ip) const {
        const h4 xc = *(const h4*)(XC + (size_t)row * D + ch);
        u32x4 lb;
#pragma unroll
        for (int e = 0; e < 4; ++e) lb[e] = elem(rp[e], ip[e], g.ba[e], g.bx[e], g.ls[e], (float)xc[e]);
        *(u32x4*)(LB + (size_t)row * D + ch) = lb;
    }
    __device__ __forceinline__ void emit8g(int row, int ch, const GateCols& g0, const GateCols& g1, const f32x4 rp0, const f32x4 ip0, const f32x4 rp1, const f32x4 ip1, const h8 xc) const {
        u32x4 lb0, lb1;
#pragma unroll
        for (int e = 0; e < 4; ++e) { lb0[e] = elem(rp0[e], ip0[e], g0.ba[e], g0.bx[e], g0.ls[e], (float)xc[e]); lb1[e] = elem(rp1[e], ip1[e], g1.ba[e], g1.bx[e], g1.ls[e], (float)xc[4 + e]); }
        unsigned* dst = LB + (size_t)row * D + ch;
        *(u32x4*)dst = lb0; *(u32x4*)(dst + 4) = lb1;
    }
};
struct EpiGates {
    EmitGates em;
    __device__ __forceinline__ void operator()(const f32x4 (&acc)[2][2][4][2], const pg::Unit& u, int wr, int wc, int fr, int fq) const {
        const int chb = (u.pn >> 1) * 256 + (u.pn & 1) * 128 + wc * 32 + 8 * fq;
        const GateCols g0 = em.cols(chb), g1 = em.cols(chb + 4);
        h8 xq[2][4];
#pragma unroll
        for (int ai = 0; ai < 2; ++ai)
#pragma unroll
            for (int m = 0; m < 4; ++m) xq[ai][m] = *(const h8*)(em.XC + (size_t)(u.pm * 256 + ai * 128 + wr * 64 + m * 16 + fr) * D + chb);
#pragma unroll
        for (int ai = 0; ai < 2; ++ai)
#pragma unroll
            for (int m = 0; m < 4; ++m) em.emit8g(u.pm * 256 + ai * 128 + wr * 64 + m * 16 + fr, chb, g0, g1, acc[ai][0][m][0], acc[ai][1][m][0], acc[ai][0][m][1], acc[ai][1][m][1], xq[ai][m]);
    }
};

template <int NCH, int SPW> __device__ __forceinline__ void thin_unit(const f16* AS, const f16* w0, const f16* w1, int s0, f32x4 (&acc)[NCH][8], int lane) {
    const int fq = lane >> 4;
    const f16* ap = AS + ((size_t)s0 * 8 * 64 + lane) * 8;
    h8 wq[SPW][NCH], aq[SPW][8];
#pragma unroll
    for (int s = 0; s < SPW; ++s) {
        wq[s][0] = *(const h8*)(w0 + s * 32 + 8 * fq); if (NCH == 2) wq[s][NCH - 1] = *(const h8*)(w1 + s * 32 + 8 * fq);
#pragma unroll
        for (int rb = 0; rb < 8; ++rb) aq[s][rb] = *(const h8*)(ap + ((size_t)s * 8 + rb) * 512);
    }
#pragma unroll
    for (int c = 0; c < NCH; ++c)
#pragma unroll
        for (int rb = 0; rb < 8; ++rb) acc[c][rb] = (f32x4){0.f, 0.f, 0.f, 0.f};
#pragma unroll
    for (int s = 0; s < SPW; ++s)
#pragma unroll
        for (int c = 0; c < NCH; ++c)
#pragma unroll
            for (int rb = 0; rb < 8; ++rb) acc[c][rb] = __builtin_amdgcn_mfma_f32_16x16x32_f16(wq[s][c], aq[s][rb], acc[c][rb], 0, 0, 0);
}
template <int NCH> __device__ __forceinline__ void thin_reduce(LAS unsigned char* lds, const f32x4 (&acc)[NCH][8], f32x4 (&tot)[NCH], int wave, int lane) {
    LAS f32x4* red = (LAS f32x4*)lds;
    __syncthreads();
#pragma unroll
    for (int c = 0; c < NCH; ++c)
#pragma unroll
        for (int rb = 0; rb < 8; ++rb) red[(wave * (NCH * 8) + c * 8 + rb) * 64 + lane] = acc[c][rb];
    __syncthreads();
#pragma unroll
    for (int c = 0; c < NCH; ++c) { f32x4 t = red[(c * 8 + wave) * 64 + lane];
#pragma unroll
        for (int w = 1; w < 8; ++w) t += red[(w * (NCH * 8) + c * 8 + wave) * 64 + lane];
        tot[c] = t; }
    __syncthreads();
}

template <class Emit> __device__ __forceinline__ void thin_gemm(LAS unsigned char* lds, const f16* AS, const f16* Bt, int ldb, int ncols, const Emit& em, const int wv_s, const int wg_lo = 0, const int wg_n = 1 << 30) {
    const int tid_ = tid_fresh(), lane = tid_ & 63, wave = tid_ >> 6, fr = lane & 15, fq = lane >> 4;
    const int nwg = wg_n < (int)gridDim.x - wg_lo ? wg_n : (int)gridDim.x - wg_lo;
    if ((int)blockIdx.x < wg_lo || (int)blockIdx.x >= wg_lo + nwg) return;
    for (int u = (int)blockIdx.x - wg_lo; u < ncols / 16; u += nwg) {
        const int n0 = u * 16;
        f32x4 acc[1][8], tot[1];
        thin_unit<1, 4>(AS, Bt + (size_t)(n0 + fr) * ldb + wave * 128, nullptr, wave * 4, acc, lane);
        thin_reduce<1>(lds, acc, tot, wave, lane);
        em.template emit<true>(__builtin_amdgcn_readfirstlane(n0 >> 8), MP + wave * 16 + fr, n0 + 4 * fq, tot[0]);
    }
}
__device__ __forceinline__ void thin_gemm_gates(LAS unsigned char* lds, const f16* AS, const f16* Wg, const EmitGates& em, const int wv_s) {
    const int tid_ = tid_fresh(), lane = tid_ & 63, wave = tid_ >> 6, fr = lane & 15, fq = lane >> 4;
    for (int u = (int)blockIdx.x; u < 64; u += (int)gridDim.x) {
        const int pn = u >> 3, g16 = u & 7;
        const int ch = (pn >> 1) * 256 + (pn & 1) * 128 + g16 * 16 + 4 * fq;
        f32x4 acc[2][8], tot[2];
        thin_unit<2, 1>(AS, Wg + (size_t)(pn * 256 + g16 * 16 + fr) * 256 + wave * 32, Wg + (size_t)(pn * 256 + 128 + g16 * 16 + fr) * 256 + wave * 32, (pn >> 1) * 8 + wave, acc, lane);
        thin_reduce<2>(lds, acc, tot, wave, lane);
        const GateCols g = em.cols(ch);
        em.emit2(MP + wave * 16 + fr, ch, g, tot[0], tot[1]);
    }
}

template <class F, class R> __device__ __forceinline__ void conv_weight(f16* dst, int nrows, int K, F src_at, R dst_row, long gtid_, long gthreads_) {
    const unsigned kc = (unsigned)K / 8u, total = (unsigned)nrows * kc, gtid = (unsigned)gtid_, gthreads = (unsigned)gthreads_;
    for (unsigned ch = gtid; ch < total; ch += 2u * gthreads) {
        const unsigned ch2 = ch + gthreads; const bool two = ch2 < total;
        const int k0 = (int)(ch / (unsigned)nrows) * 8, n = (int)(ch - (unsigned)(k0 / 8) * (unsigned)nrows);
        const int k02 = two ? (int)(ch2 / (unsigned)nrows) * 8 : k0, n2 = two ? (int)(ch2 - (unsigned)(k02 / 8) * (unsigned)nrows) : n;
        float a[8], c[8];
#pragma unroll
        for (int j = 0; j < 8; ++j) { a[j] = src_at(k0 + j, n); c[j] = src_at(k02 + j, n2); }
        h8 v, v2;
#pragma unroll
        for (int j = 0; j < 8; ++j) { v[j] = (f16)a[j]; v2[j] = (f16)c[j]; }
        *(h8*)(dst + (size_t)dst_row(n) * K + k0) = v;
        if (two) *(h8*)(dst + (size_t)dst_row(n2) * K + k02) = v2;
    }
}

constexpr int CT_WIN = NIN * 16, CT_WO0 = CT_WIN + D * 16, CT_WLIN = CT_WO0 + 2 * D * 16, CT_WLO = CT_WLIN + D * 16, CT_WA = CT_WLO + 1024 * 4, CT_WX = CT_WA + 1024 * 4, CT_TRIPS = CT_WX / 512;
static_assert(CT_WIN % 512 == 0 && CT_WX % 512 == 0, "trip granularity");
__device__ __forceinline__ void conv_trip(CParams& p, const int trip, const int tid) {
    const int it0 = __builtin_amdgcn_readfirstlane(trip * 512);
    const unsigned it = (unsigned)(it0 + tid);
    const float* base; unsigned off0, stride; f16* dst; bool valid = true;
    if (it0 < CT_WIN) {
        const unsigned kc = it / (unsigned)NIN; const int n = (int)(it - kc * (unsigned)NIN);
        int c; if (n < 2560) c = n; else if (n < 3584) c = n - 2560 + 2640; else if (n < 3648) c = n - 3584 + 2560; else if (n < 3664) c = n - 3648 + 2624; else c = -1;
        valid = c >= 0; base = p.w_in; off0 = kc * 64u * 3664u + (unsigned)(valid ? c : 0); stride = 3664u; dst = (f16*)(p.ws + WS_WIN) + (size_t)n * D + kc * 64;
    } else if (it0 < CT_WO0) { const unsigned l = it - CT_WIN, kc = l >> 10, n = l & 1023u;
        base = p.w_out0; off0 = kc * 64u * D + n; stride = D; dst = (f16*)(p.ws + WS_WO0) + (size_t)n * D + kc * 64;
    } else if (it0 < CT_WLIN) { const unsigned l = it - CT_WO0, kc = l >> 11, n = l & 2047u;
        base = p.lw_in; off0 = kc * 64u * 2u * D + n; stride = 2 * D; dst = (f16*)(p.ws + WS_WLIN) + (size_t)n * D + kc * 64;
    } else if (it0 < CT_WLO) { const unsigned l = it - CT_WLIN, kc = l >> 10, n = l & 1023u;
        base = p.lw_out; off0 = kc * 64u * D + n; stride = D; dst = (f16*)(p.ws + WS_WLO) + (size_t)n * D + kc * 64;
    } else {
        const bool isx = it0 >= CT_WA; const unsigned l = it - (isx ? CT_WA : CT_WLO), kc = l >> 10, n = l & 1023u;
        base = isx ? p.w_x : p.w_a;
        off0 = ((n >> 8) * 256u + kc * 64u) * 256u + (n & 255u); stride = 256u; dst = (f16*)(p.ws + WS_WG) + (size_t)((n >> 7) * 256u + (isx ? 128u : 0u) + (n & 127u)) * 256 + kc * 64;
    }
    float a[64];
#pragma unroll
    for (int j = 0; j < 64; ++j) a[j] = base[off0 + (unsigned)j * stride];
#pragma unroll
    for (int q = 0; q < 8; ++q) { h8 v;
#pragma unroll
        for (int e = 0; e < 8; ++e) v[e] = valid ? (f16)a[q * 8 + e] : (f16)0.f;
        *(h8*)(dst + q * 8) = v; }
}

__device__ __forceinline__ void ph0_prologue(CParams& p, LAS unsigned char* lds, const int wv_s) {
    const int tid = tid_fresh();
    const long gtid = (long)blockIdx.x * NTHR + tid, gth = (long)gridDim.x * NTHR;
    float* ADA = (float*)(p.ws + WS_ADA);
    LAS float* sc = (LAS float*)lds;
    LAS float* red = (LAS float*)(lds + 98304);
    const int cl = tid & 31, ks = tid >> 5;
    for (int item = blockIdx.x; item < 192; item += gridDim.x) {
        const int l = item / 96, cg = item % 96, col = cg * 32 + cl;
        const float* aw = p.ada_w + (size_t)l * D * 3072 + (size_t)ks * 64 * 3072 + col;
        float w[64];
#pragma unroll
        for (int i = 0; i < 64; ++i) w[i] = aw[(size_t)i * 3072];
        for (int half = 0; half < 2; ++half) {
            __syncthreads();
            for (int e = tid; e < 24 * 1024; e += NTHR) { const int r = 24 * half + (e >> 10), k = e & 1023; const float c = r < 16 ? p.c_p[r * D + k] : p.c_s[(r - 16) * D + k]; sc[e] = c * __builtin_amdgcn_rcpf(1.f + __expf(-c)); }
            __syncthreads();
            f32x2 acc[24];
            const LAS float *sc_lo = sc + ks * 64, *sc_hi = sc + 12 * 1024 + ks * 64; asm volatile("" : "+v"(sc_lo), "+v"(sc_hi));
#pragma unroll
            for (int r = 0; r < 24; ++r) acc[r] = (f32x2){0.f, 0.f};
#pragma unroll
            for (int k4 = 0; k4 < 16; ++k4) {
                const f32x2 wa = {w[4 * k4], w[4 * k4 + 1]}, wb = {w[4 * k4 + 2], w[4 * k4 + 3]};
#pragma unroll
                for (int rh = 0; rh < 2; ++rh) {
#pragma unroll
                    for (int r = 12 * rh; r < 12 * rh + 12; ++r) { const f32x4 s4 = *(const LAS f32x4*)((r < 12 ? sc_lo : sc_hi) + (r % 12) * 1024 + 4 * k4);
                        acc[r] = __builtin_elementwise_fma((f32x2){s4[0], s4[1]}, wa, acc[r]); acc[r] = __builtin_elementwise_fma((f32x2){s4[2], s4[3]}, wb, acc[r]); }
                    __builtin_amdgcn_sched_barrier(0);
                }
            }
#pragma unroll
            for (int r = 0; r < 24; ++r) red[(ks * 24 + r) * 32 + cl] = acc[r][0] + acc[r][1];
            __syncthreads();
            for (int e = tid; e < 768; e += NTHR) { const int r = e >> 5, c2 = e & 31; float s = 0.f;
                for (int q = 0; q < 16; ++q) s += red[(q * 24 + r) * 32 + c2];
                const int cc = cg * 32 + c2; ADA[((size_t)l * 48 + 24 * half + r) * 3072 + cc] = s + p.ada_b[l * 3072 + cc]; }
        }
    }
    __syncthreads();
    { float* LS = (float*)(p.ws + WS_LS); for (long i = gtid; i < D; i += gth) LS[i] = -8.f * log1pf(expf(-p.lam[i])); }
    { float* ROPE = (float*)(p.ws + WS_ROPE);
      for (long i = gtid; i < (long)(SEQ + DT) * 24; i += gth) { const int idx = (int)(i / 24), f = (int)(i % 24); const int pos = idx < SEQ ? idx : PAST + (idx - SEQ);
          float c, sn; rope_cs(pos, f < 16 ? INV32[f] : INV16[f - 16], c, sn); ROPE[i * 2] = c; ROPE[i * 2 + 1] = sn; } }
    {
        const int G = (int)gridDim.x, nada = G < 192 ? G : 192;
        const int w2 = ((int)blockIdx.x + G - nada) % G;
        for (int t = w2; t < CT_TRIPS; t += G) conv_trip(p, t, tid);
    }
}

__device__ __forceinline__ void ph_modulate(const float* xa, const float* xb, const float* ng, const float* ada, f16* H, f16* HS, const int wv_s) {
    const int tid_ = tid_fresh(), lane = tid_ & 63, gw = blockIdx.x * 8 + (tid_ >> 6), nw = gridDim.x * 8;
    for (int rp = gw; rp < MPAD / 2; rp += nw) {
        const int rows[2] = {2 * rp, 2 * rp + 1};
        f32x4 xv[2][4];
#pragma unroll
        for (int q = 0; q < 2; ++q) { const int row = rows[q];
            if (row < MT) { const float* src = row < MP ? xa + (size_t)row * D : xb + (size_t)(row - MP) * D;
#pragma unroll
                for (int i = 0; i < 4; ++i) xv[q][i] = __builtin_nontemporal_load((const f32x4*)(src + (i * 64 + lane) * 4)); }
            else {
#pragma unroll
                for (int i = 0; i < 4; ++i) xv[q][i] = (f32x4){0.f, 0.f, 0.f, 0.f}; } }
#pragma unroll
        for (int q = 0; q < 2; ++q) { const int row = rows[q];
            f16* hr = H + (size_t)row * D;
            if (row >= MT) {
#pragma unroll
                for (int i = 0; i < 4; ++i) *(h4*)(hr + (i * 64 + lane) * 4) = (h4){(f16)0.f, (f16)0.f, (f16)0.f, (f16)0.f};
                continue; }
            const float* ar = ada + (size_t)row_arow(row) * 3072;
            float ss = 0.f;
#pragma unroll
            for (int i = 0; i < 4; ++i) ss += xv[q][i][0] * xv[q][i][0] + xv[q][i][1] * xv[q][i][1] + xv[q][i][2] * xv[q][i][2] + xv[q][i][3] * xv[q][i][3];
            ss = wave_sum(ss);
            const float rs = rsqrtf(ss * (1.f / D) + EPS);
#pragma unroll
            for (int i = 0; i < 4; ++i) { const int c = (i * 64 + lane) * 4;
                const f32x4 g = *(const f32x4*)(ng + c), sh = *(const f32x4*)(ar + c), scv = *(const f32x4*)(ar + 1024 + c);
                f32x4 y;
#pragma unroll
                for (int e = 0; e < 4; ++e) y[e] = (xv[q][i][e] * rs * g[e]) * (1.f + scv[e]) + sh[e];
                if (row < MP) *(h4*)(hr + c) = to_h4(y); else *(h4*)(HS + as16_off(row - MP, c)) = to_h4(y); }
        }
    }
}

__device__ __forceinline__ void ph3_fixup(CParams& p, const int wv_s) {
    const int tid_ = tid_fresh(), lane = tid_ & 63, gw = blockIdx.x * 8 + (tid_ >> 6), nw = gridDim.x * 8;
    f16* KH = (f16*)(p.ws + WS_KH); f16* KIH = (f16*)(p.ws + WS_KIH); const float* ROPE = (const float*)(p.ws + WS_ROPE);
    const int l5 = lane & 31, ri = lane >> 4, l4 = lane & 15;
    const f32x4 kn = *(const f32x4*)(p.k_norm + l5 * 4), qn4 = *(const f32x4*)(p.q_norm + l5 * 4);
    constexpr int R = 8;
    static_assert(MT % R == 0 && MP % R == 0, "row groups never straddle the prompt / sample boundary");
    for (int row0 = gw * R; row0 < MT; row0 += nw * R) {
        float* kp[R]; f32x4 v[R], kc0[R], kc1[R];
#pragma unroll
        for (int i = 0; i < R; ++i) { const int row = row0 + i;
            kp[i] = (row >= MP ? p.out + O_KS + (size_t)(row - MP) * 256 : p.out + O_K + (size_t)row * 256) + lane * 4;
            v[i] = *(const f32x4*)kp[i];
            const float* rr = rope_row(ROPE, row_pos(row), (l5 & 3) * 4); kc0[i] = *(const f32x4*)rr; kc1[i] = *(const f32x4*)(rr + 4); }
        float* kip[2]; f32x4 w[2], ic0[2], ic1[2];
#pragma unroll
        for (int g = 0; g < 2; ++g) { const int rowi = row0 + 4 * g + ri;
            kip[g] = (rowi >= MP ? p.out + O_IKS + (size_t)(rowi - MP) * 64 : p.out + O_IK + (size_t)rowi * 64) + l4 * 4;
            w[g] = *(const f32x4*)kip[g];
            const float* rri = rope_row(ROPE, row_pos(rowi), 16 + (l4 & 1) * 4); ic0[g] = *(const f32x4*)rri; ic1[g] = *(const f32x4*)(rri + 4); }
#pragma unroll
        for (int i = 0; i < R; ++i) { const int row = row0 + i;
            float ss = v[i][0] * v[i][0] + v[i][1] * v[i][1] + v[i][2] * v[i][2] + v[i][3] * v[i][3];
            ss += __shfl_xor(ss, 1); ss += __shfl_xor(ss, 2); ss += __shfl_xor(ss, 4); ss += __shfl_xor(ss, 8); ss += __shfl_xor(ss, 16);
            const float rn = rsqrtf(ss * (1.f / 128.f) + EPS);
            f32x4 x = v[i] * rn * kn;
            const float cs4[4] = {kc0[i][0], kc0[i][2], kc1[i][0], kc1[i][2]}, sn4[4] = {kc0[i][1], kc0[i][3], kc1[i][1], kc1[i][3]};
#pragma unroll
            for (int e = 0; e < 4; ++e) { const float o = __shfl_xor(x[e], 4); if (l5 < 4) x[e] = x[e] * cs4[e] - o * sn4[e]; else if (l5 < 8) x[e] = x[e] * cs4[e] + o * sn4[e]; }
            *(f32x4*)kp[i] = x;
            if (l5 >= 8) x = x * qn4;
            *(h4*)(KH + (size_t)row * 256 + lane * 4) = to_h4(x);
        }
#pragma unroll
        for (int g = 0; g < 2; ++g) { const int rowi = row0 + 4 * g + ri;
            const float cs4[4] = {ic0[g][0], ic0[g][2], ic1[g][0], ic1[g][2]}, sn4[4] = {ic0[g][1], ic0[g][3], ic1[g][1], ic1[g][3]};
            f32x4 x = w[g];
#pragma unroll
            for (int e = 0; e < 4; ++e) { const float o = __shfl_xor(x[e], 2); if (l4 < 2) x[e] = x[e] * cs4[e] - o * sn4[e]; else if (l4 < 4) x[e] = x[e] * cs4[e] + o * sn4[e]; }
            *(f32x4*)kip[g] = x;
            const int d4 = l4 * 4;
            if (rowi >= MP) *(h4*)(KIH + (size_t)rowi * 64 + d4) = to_h4(x);
            else { const int b_ = rowi >> 11, ps = rowi & (SEQ - 1);
                *(h4*)(KIH + ((((size_t)(b_ * 64 + (ps >> 5)) * 4 + (d4 >> 4)) * 2 + ((d4 >> 3) & 1)) * 32 + (ps & 31)) * 8 + (d4 & 7)) = to_h4(x); }
        }
    }
}

#define DPP_ROW_SHR(n) (0x110 + (n))
#define DPP_ROW_BCAST15 0x142
#define DPP_ROW_BCAST31 0x143
#define dpp_f(old, src, ctrl, row_mask, bc) __int_as_float(__builtin_amdgcn_update_dpp(__float_as_int(old), __float_as_int(src), (ctrl), (row_mask), 0xf, (bc)))
__device__ __forceinline__ float wave_max_dpp(float v) {
    v = fmaxf(v, dpp_f(v, v, DPP_ROW_SHR(1), 0xf, false)); v = fmaxf(v, dpp_f(v, v, DPP_ROW_SHR(2), 0xf, false));
    v = fmaxf(v, dpp_f(v, v, DPP_ROW_SHR(4), 0xf, false)); v = fmaxf(v, dpp_f(v, v, DPP_ROW_SHR(8), 0xf, false));
    v = fmaxf(v, dpp_f(v, v, DPP_ROW_BCAST15, 0xa, false)); v = fmaxf(v, dpp_f(v, v, DPP_ROW_BCAST31, 0xc, false));
    return __int_as_float(__builtin_amdgcn_readlane(__float_as_int(v), 63)); }
__device__ __forceinline__ float wave_min_dpp(float v) {
    v = fminf(v, dpp_f(v, v, DPP_ROW_SHR(1), 0xf, false)); v = fminf(v, dpp_f(v, v, DPP_ROW_SHR(2), 0xf, false));
    v = fminf(v, dpp_f(v, v, DPP_ROW_SHR(4), 0xf, false)); v = fminf(v, dpp_f(v, v, DPP_ROW_SHR(8), 0xf, false));
    v = fminf(v, dpp_f(v, v, DPP_ROW_BCAST15, 0xa, false)); v = fminf(v, dpp_f(v, v, DPP_ROW_BCAST31, 0xc, false));
    return __int_as_float(__builtin_amdgcn_readlane(__float_as_int(v), 63)); }
__device__ __forceinline__ unsigned wave_prefix_dpp(unsigned x, unsigned& tot, int lane) {
    int v = (int)x;
    v += __builtin_amdgcn_update_dpp(0, v, DPP_ROW_SHR(1), 0xf, 0xf, true);
    v += __builtin_amdgcn_update_dpp(0, v, DPP_ROW_SHR(2), 0xf, 0xf, true);
    v += __builtin_amdgcn_update_dpp(0, v, DPP_ROW_SHR(4), 0xf, 0xf, true);
    v += __builtin_amdgcn_update_dpp(0, v, DPP_ROW_SHR(8), 0xf, 0xf, true);
    const int t0 = __builtin_amdgcn_readlane(v, 15), t1 = __builtin_amdgcn_readlane(v, 31), t2 = __builtin_amdgcn_readlane(v, 47), t3 = __builtin_amdgcn_readlane(v, 63);
    const int rowi = lane >> 4;
    const int add = rowi == 0 ? 0 : (rowi == 1 ? t0 : (rowi == 2 ? t0 + t1 : t0 + t1 + t2));
    tot = (unsigned)(t0 + t1 + t2 + t3);
    return (unsigned)(v + add);
}

__device__ __forceinline__ unsigned ord16(float sc) { const unsigned h = (unsigned)__builtin_bit_cast(unsigned short, (f16)sc); const int m = __builtin_amdgcn_sbfe((int)h, 15, 1); return (h ^ ((unsigned)m | 0x8000u)) & 0xFFFFu; }
__device__ __forceinline__ void radix_find(const LAS unsigned* hist, int k, int lane, int& B, int& r) {
    const u32x4 hc = *(const LAS u32x4*)(hist + lane * 4);
    const unsigned s4 = hc.x + hc.y + hc.z + hc.w;
    unsigned tot; const unsigned pre = wave_prefix_dpp(s4, tot, lane);
    const unsigned above = tot - pre;
    const bool mine = (above < (unsigned)k) && (above + s4 >= (unsigned)k);
    int B1 = 0, r1 = 1;
    { unsigned c = above; const unsigned hb[4] = {hc.x, hc.y, hc.z, hc.w}; bool found = false;
#pragma unroll
      for (int b = 3; b >= 0; --b) { if (!found && c + hb[b] >= (unsigned)k) { B1 = lane * 4 + b; r1 = k - (int)c; found = true; } c += hb[b]; } }
    const u64 bmn = __ballot(mine);
    const int srcl = bmn ? (int)__builtin_ctzll(bmn) : 0;
    B = __builtin_amdgcn_readlane(B1, srcl); r = __builtin_amdgcn_readlane(r1, srcl);
}
__device__ __forceinline__ int wave_max_i_dpp(int v) {
    v = max(v, __builtin_amdgcn_update_dpp(v, v, DPP_ROW_SHR(1), 0xf, 0xf, false)); v = max(v, __builtin_amdgcn_update_dpp(v, v, DPP_ROW_SHR(2), 0xf, 0xf, false));
    v = max(v, __builtin_amdgcn_update_dpp(v, v, DPP_ROW_SHR(4), 0xf, 0xf, false)); v = max(v, __builtin_amdgcn_update_dpp(v, v, DPP_ROW_SHR(8), 0xf, 0xf, false));
    v = max(v, __builtin_amdgcn_update_dpp(v, v, DPP_ROW_BCAST15, 0xa, 0xf, false)); v = max(v, __builtin_amdgcn_update_dpp(v, v, DPP_ROW_BCAST31, 0xc, 0xf, false));
    return __builtin_amdgcn_readlane(v, 63); }
__device__ __forceinline__ int wave_min_i_dpp(int v) {
    v = min(v, __builtin_amdgcn_update_dpp(v, v, DPP_ROW_SHR(1), 0xf, 0xf, false)); v = min(v, __builtin_amdgcn_update_dpp(v, v, DPP_ROW_SHR(2), 0xf, 0xf, false));
    v = min(v, __builtin_amdgcn_update_dpp(v, v, DPP_ROW_SHR(4), 0xf, 0xf, false)); v = min(v, __builtin_amdgcn_update_dpp(v, v, DPP_ROW_SHR(8), 0xf, 0xf, false));
    v = min(v, __builtin_amdgcn_update_dpp(v, v, DPP_ROW_BCAST15, 0xa, 0xf, false)); v = min(v, __builtin_amdgcn_update_dpp(v, v, DPP_ROW_BCAST31, 0xc, 0xf, false));
    return __builtin_amdgcn_readlane(v, 63); }
__device__ __forceinline__ u64 wave_select_mask(const LAS unsigned short* S, int n, int k, LAS unsigned* hist, LAS u64* mb, int lane) {
    if (n <= k) { const int m_ = n - 64 * lane; return m_ >= 64 ? ~0ull : (m_ <= 0 ? 0ull : ((1ull << m_) - 1ull)); }
    int d[32]; int kmin = 0xFFFF, kmax = 0;
#pragma unroll
    for (int j = 0; j < 32; ++j) { const int idx = j * 64 + lane; const int key = (idx < n) ? (int)S[idx] : -1; d[j] = key; kmax = max(kmax, key); kmin = min(kmin, key < 0 ? 0xFFFF : key); }
    kmin = wave_min_i_dpp(kmin); kmax = wave_max_i_dpp(kmax);
    const int span = kmax - kmin;
    const int sh = span < 256 ? 0 : (24 - __builtin_clz((unsigned)span));
    const int dump = 256 + lane;
    *(LAS u32x4*)(hist + lane * 4) = (u32x4){0u, 0u, 0u, 0u};
    WSYNC();
#pragma unroll
    for (int j = 0; j < 32; ++j) { const bool ok = d[j] >= 0; d[j] = d[j] - kmin;
        __hip_atomic_fetch_add(&hist[ok ? (d[j] >> sh) : dump], 1u, __ATOMIC_RELAXED, __HIP_MEMORY_SCOPE_WORKGROUP); }
    WSYNC();
    int B1, r1; radix_find(hist, k, lane, B1, r1);
    WSYNC();
    *(LAS u32x4*)(hist + lane * 4) = (u32x4){0u, 0u, 0u, 0u};
    WSYNC();
    const int lowmask = (1 << sh) - 1;
#pragma unroll
    for (int j = 0; j < 32; ++j) { const bool in1 = (d[j] >= 0) && ((d[j] >> sh) == B1);
        __hip_atomic_fetch_add(&hist[in1 ? (d[j] & lowmask) : dump], 1u, __ATOMIC_RELAXED, __HIP_MEMORY_SCOPE_WORKGROUP); }
    WSYNC();
    int B2, r2; radix_find(hist, r1, lane, B2, r2);
    const int thr = (B1 << sh) + B2;
    WSYNC();
#pragma unroll
    for (int j = 0; j < 32; ++j) { const u64 bm = __ballot(d[j] >= thr); if (lane == 0) mb[j] = bm; }
    WSYNC();
    const u64 res = mb[lane & 31];
    WSYNC();
    return res;
}

__device__ __forceinline__ void qi_rope(h8& a0, const float* ROPE, int pos, int hh) {
    const float* rr = rope_row(ROPE, pos, 16);
    const f32x4 t0 = *(const f32x4*)rr, t1 = *(const f32x4*)(rr + 4), t2 = *(const f32x4*)(rr + 8), t3 = *(const f32x4*)(rr + 12);
    const float cs[16] = {t0[0], t0[1], t0[2], t0[3], t1[0], t1[1], t1[2], t1[3], t2[0], t2[1], t2[2], t2[3], t3[0], t3[1], t3[2], t3[3]};
#pragma unroll
    for (int jj = 0; jj < 8; ++jj) { const float c = cs[2 * jj], sn = cs[2 * jj + 1]; const float mine = (float)a0[jj], other = __shfl_xor(mine, 32);
        a0[jj] = (f16)(hh ? (mine * c + other * sn) : (mine * c - other * sn)); }
}
#define PHA_COMMON \
    const int tid = tid_fresh(), lane = tid & 63, wave = tid >> 6, r = lane & 31, hh = lane >> 5; \
    const f16* QI = (const f16*)(p.ws + WS_QI); const f16* KIH = (const f16*)(p.ws + WS_KIH); const float* WI = (const float*)(p.ws + WS_WI); \
    unsigned* MASK = (unsigned*)(p.ws + WS_MASK); float* SCS = (float*)(p.ws + WS_SCS); \
    const int qsel = (r >> 2) & 1, ahead = (r & 3) + 4 * (r >> 3); (void)tid; (void)MASK; (void)SCS; (void)KIH; (void)qsel; (void)ahead; (void)WI; (void)QI;
__device__ __forceinline__ void phA_sample(CParams& p, LAS unsigned char* lds, const int wv_s) {
    PHA_COMMON
    for (int it = blockIdx.x * 8 + wave; it < DB * NPG; it += gridDim.x * 8) {
        const int b = it / NPG, pg_ = it % NPG; const int phys = p.page_table[b * NPG + pg_];
        const float* kp0 = p.cache_ik + ((size_t)phys * PAGE + r) * 64 + 8 * hh;
        f32x4 raw[2][8];
#pragma unroll
        for (int s = 0; s < 4; ++s) { raw[0][2 * s] = *(const f32x4*)(kp0 + 16 * s); raw[0][2 * s + 1] = *(const f32x4*)(kp0 + 16 * s + 4); }
        h8 af[2][4]; float wv[2][16];
#pragma unroll
        for (int mt = 0; mt < 2; ++mt) {
            const int rowa = MP + b * 4 + 2 * mt + qsel, roww = MP + b * 4 + 2 * mt + hh;
#pragma unroll
            for (int s = 0; s < 4; ++s) af[mt][s] = *(const h8*)(QI + (size_t)rowa * D + ahead * 64 + 16 * s + 8 * hh);
            qi_rope(af[mt][0], (const float*)(p.ws + WS_ROPE), PAST + 2 * mt + qsel, hh);
#pragma unroll
            for (int q4 = 0; q4 < 4; ++q4) { const f32x4 w4 = *(const f32x4*)(WI + (size_t)roww * 16 + q4 * 4); wv[mt][q4 * 4] = w4[0]; wv[mt][q4 * 4 + 1] = w4[1]; wv[mt][q4 * 4 + 2] = w4[2]; wv[mt][q4 * 4 + 3] = w4[3]; }
        }
#pragma unroll
        for (int kt = 0; kt < 4; ++kt) {
            if (kt < 3) { const float* kp = kp0 + (size_t)(kt + 1) * 32 * 64;
#pragma unroll
                for (int s = 0; s < 4; ++s) { raw[(kt + 1) & 1][2 * s] = *(const f32x4*)(kp + 16 * s); raw[(kt + 1) & 1][2 * s + 1] = *(const f32x4*)(kp + 16 * s + 4); } }
            h8 bf[4];
#pragma unroll
            for (int s = 0; s < 4; ++s) { const f32x4 a = raw[kt & 1][2 * s], c = raw[kt & 1][2 * s + 1];
                bf[s][0] = (f16)a[0]; bf[s][1] = (f16)a[1]; bf[s][2] = (f16)a[2]; bf[s][3] = (f16)a[3]; bf[s][4] = (f16)c[0]; bf[s][5] = (f16)c[1]; bf[s][6] = (f16)c[2]; bf[s][7] = (f16)c[3]; }
#pragma unroll
            for (int mt = 0; mt < 2; ++mt) {
                f32x16 acc;
#pragma unroll
                for (int e = 0; e < 16; ++e) acc[e] = 0.f;
#pragma unroll
                for (int s = 0; s < 4; ++s) acc = __builtin_amdgcn_mfma_f32_32x32x16_f16(af[mt][s], bf[s], acc, 0, 0, 0);
                float sc = 0.f;
#pragma unroll
                for (int e = 0; e < 16; ++e) sc += wv[mt][e] * relu_f(acc[e]);
                SCS[(size_t)(b * 4 + 2 * mt + hh) * LSP + pg_ * PAGE + kt * 32 + r] = sc;
            }
        }
    }
    for (int b = blockIdx.x * 8 + wave; b < DB; b += gridDim.x * 8) {
        const int t = lane >> 4, h = lane & 15; const int rowq = MP + b * 4 + t;
        const float w = WI[(size_t)rowq * 16 + h];
        float dots[4] = {0.f, 0.f, 0.f, 0.f};
        h8 qr0 = *(const h8*)(QI + (size_t)rowq * D + h * 64), qr1 = *(const h8*)(QI + (size_t)rowq * D + h * 64 + 8);
#pragma unroll
        for (int jj = 0; jj < 8; ++jj) { const float* rr = rope_row((const float*)(p.ws + WS_ROPE), PAST + t, 16 + jj); const float c = rr[0], sn = rr[1]; const float x1 = (float)qr0[jj], x2 = (float)qr1[jj]; qr0[jj] = (f16)(x1 * c - x2 * sn); qr1[jj] = (f16)(x2 * c + x1 * sn); }
#pragma unroll
        for (int d0 = 0; d0 < 64; d0 += 8) {
            const h8 qv = d0 == 0 ? qr0 : (d0 == 8 ? qr1 : *(const h8*)(QI + (size_t)rowq * D + h * 64 + d0));
#pragma unroll
            for (int t2 = 0; t2 < 4; ++t2) { const h8 kv = *(const h8*)(KIH + (size_t)(MP + b * 4 + t2) * 64 + d0);
#pragma unroll
                for (int j = 0; j < 8; ++j) dots[t2] += (float)qv[j] * (float)kv[j]; }
        }
#pragma unroll
        for (int t2 = 0; t2 < 4; ++t2) { float s = w * fmaxf(dots[t2], 0.f);
            s += __shfl_xor(s, 1); s += __shfl_xor(s, 2); s += __shfl_xor(s, 4); s += __shfl_xor(s, 8);
            if (h == 0) SCS[(size_t)(b * 4 + t) * LSP + PAST + t2] = (t2 <= t) ? s : -3.0e38f; }
    }
}
template <bool SELECT> __device__ __forceinline__ void phA_prompt(CParams& p, LAS unsigned char* lds, const int wv_s) {
    PHA_COMMON
    LAS unsigned short* S = (LAS unsigned short*)lds + wave * 8192;
    LAS unsigned* hist = (LAS unsigned*)(lds + LDS_AUX + wave * 1536);
    LAS u64* mb = (LAS u64*)(lds + LDS_AUX + wave * 1536 + 1280);
    const float* ROPE = (const float*)(p.ws + WS_ROPE);
    if (blockIdx.x < 256)
    for (int j = 0; j < 4; ++j) {
        const int wq = blockIdx.x >> 4, b = blockIdx.x & 15;
        const int qt = (j == 0) ? wq : (j == 1 ? 31 - wq : (j == 2 ? 32 + wq : 63 - wq));
        const int q0 = qt * 32 + 4 * wv_s;
        const size_t tok0 = (size_t)b * SEQ;
        h8 af[2][4]; float wv[2][16];
#pragma unroll
        for (int mt = 0; mt < 2; ++mt) {
#pragma unroll
            for (int s = 0; s < 4; ++s) af[mt][s] = *(const h8*)(QI + (tok0 + q0 + 2 * mt + qsel) * D + ahead * 64 + 16 * s + 8 * hh);
            qi_rope(af[mt][0], ROPE, q0 + 2 * mt + qsel, hh);
#pragma unroll
            for (int q4 = 0; q4 < 4; ++q4) { const f32x4 w4 = *(const f32x4*)(WI + (tok0 + q0 + 2 * mt + hh) * 16 + q4 * 4); wv[mt][q4 * 4] = w4[0]; wv[mt][q4 * 4 + 1] = w4[1]; wv[mt][q4 * 4 + 2] = w4[2]; wv[mt][q4 * 4 + 3] = w4[3]; }
        }
        const int nkt = (q0 + 3) / 32 + 1;
        const f16* kbase = KIH + (size_t)b * 64 * 2048; const unsigned loff = (unsigned)lane * 8u;
        h8 bq[4][4];
#pragma unroll
        for (int u = 0; u < 4; ++u) { const int kk = u < nkt ? u : nkt - 1; const f16* kp = kbase + (size_t)kk * 2048;
#pragma unroll
            for (int s = 0; s < 4; ++s) bq[u][s] = *(const h8*)(kp + loff + 512 * s); }
#define IX_CHAIN(ACC, MT, BQ) { _Pragma("unroll") for (int e = 0; e < 16; ++e) ACC[e] = 0.f; \
        _Pragma("unroll") for (int s = 0; s < 4; ++s) ACC = __builtin_amdgcn_mfma_f32_32x32x16_f16(af[MT][s], BQ[s], ACC, 0, 0, 0); }
#define IX_SUM(ACC, MT, KT) { float sa = 0.f, sb = 0.f; _Pragma("unroll") for (int e = 0; e < 16; e += 2) { sa += wv[MT][e] * relu_f(ACC[e]); sb += wv[MT][e + 1] * relu_f(ACC[e + 1]); } \
        S[(2 * (MT) + hh) * 2048 + (KT) * 32 + r] = (unsigned short)ord16(sa + sb); }
#define IX_MIX() { _Pragma("unroll") for (int i = 0; i < 4; ++i) { __builtin_amdgcn_sched_group_barrier(0x008, 1, 0); __builtin_amdgcn_sched_group_barrier(0x002, 8, 0); } }
        f32x16 accA, accB;
        IX_CHAIN(accA, 0, bq[0])
        for (int kt0 = 0; kt0 < nkt; kt0 += 4) {
#pragma unroll
            for (int u = 0; u < 4; ++u) {
                const int kt = kt0 + u, un = (u + 1) & 3;
                IX_CHAIN(accB, 1, bq[u])
                IX_SUM(accA, 0, kt)
                IX_MIX()
                { const int kn = kt + 4; const int kk = kn < nkt ? kn : nkt - 1; const f16* kp = kbase + (size_t)kk * 2048;
#pragma unroll
                  for (int s = 0; s < 4; ++s) bq[u][s] = *(const h8*)(kp + loff + 512 * s); }
                IX_CHAIN(accA, 0, bq[un])
                IX_SUM(accB, 1, kt)
                IX_MIX()
            }
        }
#undef IX_CHAIN
#undef IX_SUM
#undef IX_MIX
        WSYNC();
        if (SELECT)
        for (int qq = 0; qq < 4; ++qq) {
            const int pos = q0 + qq; const int n = pos + 1;
            const u64 mine = wave_select_mask(S + qq * 2048, n, 256, hist, mb, lane);
            if (lane < 32) *(u64*)(MASK + (tok0 + pos) * 64 + lane * 2) = mine;
        }
        WSYNC();
    }
}

__device__ __forceinline__ void phB_sample(CParams& p, LAS unsigned char* lds, const int wv_s) {
    const int tid = tid_fresh(), lane = tid & 63, wave = tid >> 6;
    if (blockIdx.x >= MS) return;
    const int row = blockIdx.x;
    const int b = row >> 2, t = row & 3; const int n = PAST + t + 1;
    LAS unsigned* hist = (LAS unsigned*)(lds + LDS_AUX);
    LAS float* cand = (LAS float*)(lds + LDS_AUX + 4096);
    LAS float* red = (LAS float*)(lds + LDS_AUX + 4352);
    LAS int* idxl = (LAS int*)(lds + LDS_AUX + 4864);
    LAS int* rowl = (LAS int*)(lds + LDS_AUX + 5888);
    LAS float* qs = (LAS float*)(lds + LDS_AUX + 6912);
    LAS float* s2 = (LAS float*)(lds + LDS_AUX + 11008);
    LAS unsigned* cnt = (LAS unsigned*)(red + 16);
    const float* SCS = (const float*)(p.ws + WS_SCS) + (size_t)row * LSP;
    const f16* Q = (const f16*)(p.ws + WS_Q) + (size_t)(MP + row) * D;
    constexpr int NV = 33;
    float v[NV];
#pragma unroll
    for (int j = 0; j < NV; ++j) { const int i = j * NTHR + tid; v[j] = (i < n) ? SCS[i] : -3.0e38f; }
    __syncthreads();
    qs[tid] = (float)Q[tid]; qs[tid + NTHR] = (float)Q[tid + NTHR];
    if (tid < 256) { idxl[tid] = -1; rowl[tid] = 0; }
    __syncthreads();
    {
        const float a = qs[wave * 128 + lane], b2 = qs[wave * 128 + 64 + lane];
        const float rn = rsqrtf(wave_sum(a * a + b2 * b2) * (1.f / 128.f) + EPS) * 0.12751743f;
        float ya = a * rn * p.q_norm[lane], yb = b2 * rn * p.q_norm[64 + lane];
        const float oth = __shfl_xor(ya, 16);
        if (lane < 32) { const float* rr = rope_row((const float*)(p.ws + WS_ROPE), PAST + t, lane & 15); const float c = rr[0], sn = rr[1]; ya = lane < 16 ? (ya * c - oth * sn) : (ya * c + oth * sn); }
        qs[wave * 128 + lane] = ya; qs[wave * 128 + 64 + lane] = yb;
    }
    float lo = 3.0e38f, hi = -3.0e38f;
#pragma unroll
    for (int j = 0; j < NV; ++j) { hi = fmaxf(hi, v[j]); lo = fminf(lo, (j * NTHR + tid < n) ? v[j] : 3.0e38f); }
    lo = wave_min_dpp(lo); hi = wave_max_dpp(hi);
    if (lane == 0) { red[wave] = lo; red[8 + wave] = hi; }
    __syncthreads();
    lo = red[0]; hi = red[8];
#pragma unroll
    for (int w = 1; w < 8; ++w) { lo = fminf(lo, red[w]); hi = fmaxf(hi, red[8 + w]); }
    float thr = lo; int k = 256;
    for (int iter = 0; iter < 12; ++iter) {
        if (!(hi > lo)) { thr = lo; break; }
        const float scale = 1024.0f / (hi - lo);
        __syncthreads();
        if (tid < 256) *(LAS u32x4*)(hist + tid * 4) = (u32x4){0u, 0u, 0u, 0u};
        if (tid == 0) *cnt = 0u;
        __syncthreads();
#pragma unroll
        for (int j = 0; j < NV; ++j) { const float x = v[j];
            if (x >= lo && x <= hi) { int bb = (int)((x - lo) * scale); bb = bb > 1023 ? 1023 : bb; __hip_atomic_fetch_add(&hist[bb], 1u, __ATOMIC_RELAXED, __HIP_MEMORY_SCOPE_WORKGROUP); } }
        __syncthreads();
        u32x4 hc[4]; unsigned s16 = 0u;
#pragma unroll
        for (int q = 0; q < 4; ++q) { hc[q] = *(const LAS u32x4*)(hist + lane * 16 + q * 4); s16 += hc[q].x + hc[q].y + hc[q].z + hc[q].w; }
        unsigned tot; const unsigned pre = wave_prefix_dpp(s16, tot, lane);
        const unsigned above = tot - pre;
        const bool mine = (above < (unsigned)k) && (above + s16 >= (unsigned)k);
        int B1 = 0, r = 1, m = 0;
        { unsigned c = above; bool found = false;
#pragma unroll
          for (int q = 3; q >= 0; --q) { const unsigned hb[4] = {hc[q].x, hc[q].y, hc[q].z, hc[q].w};
#pragma unroll
            for (int e = 3; e >= 0; --e) { if (!found && c + hb[e] >= (unsigned)k) { B1 = lane * 16 + q * 4 + e; r = k - (int)c; m = (int)hb[e]; found = true; } c += hb[e]; } } }
        const u64 bmn = __ballot(mine);
        const int srcl = bmn ? (int)__builtin_ctzll(bmn) : 0;
        B1 = __builtin_amdgcn_readlane(B1, srcl); r = __builtin_amdgcn_readlane(r, srcl); m = __builtin_amdgcn_readlane(m, srcl);
        if (m <= 64) {
            if (tid < 64) cand[tid] = -3.0e38f;
            __syncthreads();
#pragma unroll
            for (int j = 0; j < NV; ++j) { const float x = v[j];
                if (x >= lo && x <= hi) { int bb = (int)((x - lo) * scale); bb = bb > 1023 ? 1023 : bb;
                    if (bb == B1) { const unsigned slot = __hip_atomic_fetch_add(cnt, 1u, __ATOMIC_RELAXED, __HIP_MEMORY_SCOPE_WORKGROUP); if (slot < 64u) cand[slot] = x; } } }
            __syncthreads();
            const float c = cand[lane]; int gt = 0, ge = 0;
            const int m4 = (m + 3) >> 2;
            for (int j4 = 0; j4 < m4; ++j4) { const f32x4 cj = *(const LAS f32x4*)(cand + j4 * 4);
#pragma unroll
                for (int e = 0; e < 4; ++e) { gt += (cj[e] > c) ? 1 : 0; ge += (cj[e] >= c) ? 1 : 0; } }
            const u64 bm2 = __ballot(lane < m && gt < r && ge >= r);
            const int s2l = bm2 ? (int)__builtin_ctzll(bm2) : 0;
            thr = __int_as_float(__builtin_amdgcn_readlane(__float_as_int(c), s2l));
            break;
        } else {
            float nlo = 3.0e38f, nhi = -3.0e38f;
#pragma unroll
            for (int j = 0; j < NV; ++j) { const float x = v[j];
                if (x >= lo && x <= hi) { int bb = (int)((x - lo) * scale); bb = bb > 1023 ? 1023 : bb; if (bb == B1) { nlo = fminf(nlo, x); nhi = fmaxf(nhi, x); } } }
            nlo = wave_min_dpp(nlo); nhi = wave_max_dpp(nhi);
            if (lane == 0) { red[32 + wave] = nlo; red[40 + wave] = nhi; }
            __syncthreads();
            lo = red[32]; hi = red[40];
#pragma unroll
            for (int w = 1; w < 8; ++w) { lo = fminf(lo, red[32 + w]); hi = fmaxf(hi, red[40 + w]); }
            k = r; thr = lo;
        }
    }
    {
        int cntw = 0;
#pragma unroll
        for (int j = 0; j < NV; ++j) cntw += __popcll(__ballot((j * NTHR + tid < n) && (v[j] >= thr)));
        LAS int* wc = (LAS int*)(red + 48);
        __syncthreads();
        if (lane == 0) wc[wave] = cntw;
        __syncthreads();
        int base = 0;
        for (int w = 0; w < wave; ++w) base += wc[w];
#pragma unroll
        for (int j = 0; j < NV; ++j) { const bool sel = (j * NTHR + tid < n) && (v[j] >= thr);
            const u64 bm = __ballot(sel);
            if (sel) { const int slot = base + __popcll(bm & ((1ull << lane) - 1ull)); if (slot < 256) idxl[slot] = j * NTHR + tid; }
            base += __popcll(bm); }
    }
    __syncthreads();
    if (tid < 256) { const int idx = idxl[tid]; int ro = 0;
        if (idx >= 0) { if (idx < PAST) ro = p.page_table[b * NPG + (idx >> 7)] * PAGE + (idx & 127); else ro = -(idx - PAST + 1); }
        rowl[tid] = ro; }
    __syncthreads();
    for (int kv = 0; kv < 2; ++kv) {
    {
        const int slot = tid >> 1, dh = tid & 1; const int idx = idxl[slot]; const int ro = rowl[slot];
        float a4[4] = {0.f, 0.f, 0.f, 0.f};
        if (idx >= 0) {
            const float* kp = ((ro >= 0) ? p.cache_k + (size_t)ro * 256 : p.out + O_KS + (size_t)(b * 4 + (-ro - 1)) * 256) + kv * 128 + dh * 64;
            f32x4 kk[16];
#pragma unroll
            for (int c = 0; c < 16; ++c) kk[c] = *(const f32x4*)(kp + c * 4);
#pragma unroll
            for (int c = 0; c < 16; ++c)
#pragma unroll
                for (int h = 0; h < 4; ++h) { const f32x4 qh = *(const LAS f32x4*)(qs + (kv * 4 + h) * 128 + dh * 64 + c * 4); a4[h] += kk[c][0] * qh[0] + kk[c][1] * qh[1] + kk[c][2] * qh[2] + kk[c][3] * qh[3]; }
        }
#pragma unroll
        for (int h = 0; h < 4; ++h) { a4[h] += __shfl_xor(a4[h], 1); if (dh == 0) s2[h * 256 + slot] = idx >= 0 ? a4[h] : -3.0e38f; }
    }
    __syncthreads();
    if (wave < 4) {
        LAS float* sh = s2 + wave * 256; float x[4]; float mx = -3.0e38f;
#pragma unroll
        for (int i = 0; i < 4; ++i) { x[i] = sh[i * 64 + lane]; mx = fmaxf(mx, x[i]); }
        mx = wave_max(mx); float sum = 0.f;
#pragma unroll
        for (int i = 0; i < 4; ++i) { x[i] = (x[i] > -1.0e38f) ? __builtin_amdgcn_exp2f(x[i] - mx) : 0.f; sum += x[i]; }
        sum = wave_sum(sum); const float inv = 1.f / sum;
#pragma unroll
        for (int i = 0; i < 4; ++i) sh[i * 64 + lane] = x[i] * inv;
    }
    LAS float* Vs = (LAS float*)lds;
    { const int slot = tid >> 1, half = tid & 1; const int ro = rowl[slot];
      const float* vp = ((ro >= 0) ? p.cache_v + (size_t)ro * 256 : p.out + O_VS + (size_t)(b * 4 + (-ro - 1)) * 256) + kv * 128 + half * 64;
      f32x4 tmp[16];
#pragma unroll
      for (int c = 0; c < 16; ++c) tmp[c] = *(const f32x4*)(vp + c * 4);
#pragma unroll
      for (int c = 0; c < 16; ++c) *(LAS f32x4*)(Vs + slot * 128 + half * 64 + c * 4) = tmp[c]; }
    __syncthreads();
    { const int hl = tid >> 7, d = tid & 127, head = kv * 4 + hl; float o = 0.f;
      const LAS float* ph = s2 + hl * 256;
#pragma unroll 8
      for (int slot = 0; slot < 256; ++slot) o += ph[slot] * Vs[slot * 128 + d];
      const size_t oi = (size_t)(MP + row) * D + head * 128 + d;
      ((f16*)(p.ws + WS_AOS))[as16_off(row, head * 128 + d)] = (f16)(o * silu_f((float)((const f16*)(p.ws + WS_SG))[oi])); }
    __syncthreads();
    }
}

__device__ __forceinline__ void q_prep(h8 (&qf)[8], const float* qn, const float* ROPE, int pos, int hh) {
    float ss = 0.f;
#pragma unroll
    for (int s = 0; s < 8; ++s)
#pragma unroll
        for (int jj = 0; jj < 8; ++jj) { const float x = (float)qf[s][jj]; ss += x * x; }
    ss += __shfl_xor(ss, 32);
    const float rn = rsqrtf(ss * (1.f / 128.f) + EPS) * 0.12751743f;
    float y0[8], y1[8];
    { const f32x4 g0 = *(const f32x4*)(qn + 8 * hh), g1 = *(const f32x4*)(qn + 8 * hh + 4), g2 = *(const f32x4*)(qn + 16 + 8 * hh), g3 = *(const f32x4*)(qn + 16 + 8 * hh + 4);
#pragma unroll
      for (int jj = 0; jj < 8; ++jj) { y0[jj] = (float)qf[0][jj] * rn * (jj < 4 ? g0[jj & 3] : g1[jj & 3]); y1[jj] = (float)qf[1][jj] * rn * (jj < 4 ? g2[jj & 3] : g3[jj & 3]); } }
#pragma unroll
    for (int s = 2; s < 8; ++s)
#pragma unroll
        for (int jj = 0; jj < 8; ++jj) qf[s][jj] = (f16)((float)qf[s][jj] * rn);
    const float* rr = rope_row(ROPE, pos, 8 * hh);
    const f32x4 t0 = *(const f32x4*)rr, t1 = *(const f32x4*)(rr + 4), t2 = *(const f32x4*)(rr + 8), t3 = *(const f32x4*)(rr + 12);
    const float cs[16] = {t0[0], t0[1], t0[2], t0[3], t1[0], t1[1], t1[2], t1[3], t2[0], t2[1], t2[2], t2[3], t3[0], t3[1], t3[2], t3[3]};
#pragma unroll
    for (int jj = 0; jj < 8; ++jj) { const float c = cs[2 * jj], sn = cs[2 * jj + 1]; qf[0][jj] = (f16)(y0[jj] * c - y1[jj] * sn); qf[1][jj] = (f16)(y1[jj] * c + y0[jj] * sn); }
}

__device__ __forceinline__ float xhalf_max(float x) { const auto r = __builtin_amdgcn_permlane32_swap(__float_as_uint(x), __float_as_uint(x), false, false); return fmaxf(__uint_as_float(r[0]), __uint_as_float(r[1])); }
__device__ __forceinline__ float xhalf_sum(float x) { const auto r = __builtin_amdgcn_permlane32_swap(__float_as_uint(x), __float_as_uint(x), false, false); return __uint_as_float(r[0]) + __uint_as_float(r[1]); }
__device__ __forceinline__ void attn_tile64(const LAS f16* kb, const LAS f16* vb, unsigned mlo, unsigned mhi, const h8 (&qf)[8], f32x16 (&oacc)[4], float& mrun, float& lrun, int r, int hh) {
    constexpr int KROW = 136, VROW = 72;
    f32x16 sacc[2];
#pragma unroll
    for (int kb2 = 0; kb2 < 2; ++kb2) {
#pragma unroll
        for (int e = 0; e < 16; ++e) sacc[kb2][e] = 0.f;
#pragma unroll
        for (int s = 0; s < 8; ++s) { const h8 kf = *(const LAS h8*)(kb + (32 * kb2 + r) * KROW + 16 * s + 8 * hh); sacc[kb2] = __builtin_amdgcn_mfma_f32_32x32x16_f16(kf, qf[s], sacc[kb2], 0, 0, 0); }
    }
    float sv[32]; float mx = -3.0e38f;
#pragma unroll
    for (int kb2 = 0; kb2 < 2; ++kb2) {
        const int mwb = (int)((kb2 ? mhi : mlo) >> (4 * hh));
#pragma unroll
        for (int e = 0; e < 16; ++e) {
            const int t = __builtin_amdgcn_sbfe(mwb, (e & 3) + 8 * (e >> 2), 1);
            const int sb = (__float_as_int(sacc[kb2][e]) & t) | ((int)0xFF800000 & ~t);
            sv[16 * kb2 + e] = __int_as_float(sb); mx = fmaxf(mx, sv[16 * kb2 + e]);
        }
    }
    mx = xhalf_max(mx);
    if (__any(mx - mrun > 8.f)) {
        const float mnew = fmaxf(mrun, mx); const float alpha = __builtin_amdgcn_exp2f(mrun - mnew);
        lrun *= alpha; mrun = mnew;
#pragma unroll
        for (int mt = 0; mt < 4; ++mt)
#pragma unroll
            for (int e = 0; e < 16; ++e) oacc[mt][e] *= alpha;
    }
    float rsum = 0.f;
#pragma unroll
    for (int e = 0; e < 32; ++e) { sv[e] = __builtin_amdgcn_exp2f(sv[e] - mrun); rsum += sv[e]; }
    rsum = xhalf_sum(rsum);
    lrun += rsum;
    typedef _Float16 h2t __attribute__((ext_vector_type(2)));
    h8 pf[4];
#pragma unroll
    for (int s2 = 0; s2 < 4; ++s2)
#pragma unroll
        for (int jj = 0; jj < 4; ++jj) { const h2t pk = __builtin_bit_cast(h2t, __builtin_amdgcn_cvt_pkrtz(sv[8 * s2 + 2 * jj], sv[8 * s2 + 2 * jj + 1])); pf[s2][2 * jj] = pk[0]; pf[s2][2 * jj + 1] = pk[1]; }
#pragma unroll
    for (int mt = 0; mt < 4; ++mt)
#pragma unroll
        for (int s2 = 0; s2 < 4; ++s2) {
            const h8 vf = *(const LAS h8*)(vb + (32 * mt + r) * VROW + 16 * s2 + 8 * hh);
            oacc[mt] = __builtin_amdgcn_mfma_f32_32x32x16_f16(vf, pf[s2], oacc[mt], 0, 0, 0);
        }
}

__device__ __forceinline__ void phB_attention(CParams& p, LAS unsigned char* lds, const int wv_s) {
    const int tid = tid_fresh(), lane = tid & 63, wave = tid >> 6, r = lane & 31, hh = lane >> 5;
    const f16* Q = (const f16*)(p.ws + WS_Q); const f16* KH = (const f16*)(p.ws + WS_KH); const f16* VT = (const f16*)(p.ws + WS_VT);
    const f16* SG = (const f16*)(p.ws + WS_SG); f16* AO = (f16*)(p.ws + WS_AO); const unsigned* MASK = (const unsigned*)(p.ws + WS_MASK);
    constexpr int KROW = 136, VROW = 72;
    constexpr int KBUF = 64 * KROW, VBUF = 128 * VROW;
    LAS f16* Kb = (LAS f16*)lds;
    LAS f16* Vb = (LAS f16*)(lds + 2 * KBUF * 2);
    LAS u64* MK = (LAS u64*)(lds + 2 * KBUF * 2 + 2 * VBUF * 2) + wave * 256;
    if (blockIdx.x >= 256) return;
    for (int j = 0; j < 4; ++j) {
        const int bk = blockIdx.x & 31, b = bk >> 1, kvh = bk & 1, x = blockIdx.x >> 5;
        const unsigned qpk = x == 0 ? 0x1f110100u : x == 1 ? 0x1b0f0403u : x == 2 ? 0x150d0807u : x == 3 ? 0x100c0b0au : x == 4 ? 0x1e1d0e02u : x == 5 ? 0x1c181205u : x == 6 ? 0x1a171406u : 0x19161309u;
        const int qt = (int)((qpk >> (8 * j)) & 0xFFu);
        const int q0 = qt * 64; const size_t tok0 = (size_t)b * SEQ;
        const int query = q0 + 8 * wave + (r >> 2), head = kvh * 4 + (r & 3);
        h8 qf[8];
#pragma unroll
        for (int s = 0; s < 8; ++s) qf[s] = *(const h8*)(Q + (tok0 + query) * D + head * 128 + 16 * s + 8 * hh);
        q_prep(qf, p.q_norm, (const float*)(p.ws + WS_ROPE), query, hh);
        f32x16 oacc[4];
#pragma unroll
        for (int mt = 0; mt < 4; ++mt)
#pragma unroll
            for (int e = 0; e < 16; ++e) oacc[mt][e] = 0.f;
        float mrun = -1.0e30f, lrun = 0.f;
        const int nkt = qt + 1;
        const f16* kg = KH + (tok0 + (tid >> 4)) * 256 + kvh * 128 + (tid & 15) * 8;
        const f16* vg = VT + ((size_t)(b * 2 + kvh) * 128 + (tid >> 3)) * SEQ + (tid & 7) * 8;
        LAS f16* kl = Kb + (tid >> 4) * KROW + (tid & 15) * 8;
        LAS f16* vl = Vb + (tid >> 3) * VROW + (tid & 7) * 8;
        __syncthreads();
        h8 k0 = *(const h8*)kg, k1 = *(const h8*)(kg + (size_t)32 * 256), v0 = *(const h8*)vg, v1 = *(const h8*)(vg + (size_t)64 * SEQ);
        {
            const int mq = lane >> 3; const u64* mgq = (const u64*)(MASK + (tok0 + q0 + 8 * wave + mq) * 64);
#pragma unroll
            for (int i = 0; i < 4; ++i) { const int tl = (lane & 7) + 8 * i; if (tl < nkt) MK[mq * 32 + tl] = mgq[tl]; }
        }
        *(LAS h8*)kl = k0; *(LAS h8*)(kl + 32 * KROW) = k1; *(LAS h8*)vl = v0; *(LAS h8*)(vl + 64 * VROW) = v1;
#define AT_GLD(DST, PTR) asm volatile("global_load_dwordx4 %0, %1, off" : "=v"(DST) : "v"(PTR) : "memory")
#define AT_LOAD(K0, K1, V0, V1, T) { const int ti_ = (T) < nkt ? (T) : nkt - 1; const f16* kgn = kg + (size_t)ti_ * 64 * 256; const f16* vgn = vg + ti_ * 64; \
            AT_GLD(K0, kgn); AT_GLD(K1, kgn + (size_t)32 * 256); AT_GLD(V0, vgn); AT_GLD(V1, vgn + (size_t)64 * SEQ); }
#define AT_WAIT(N, K0, K1, V0, V1) asm volatile("s_waitcnt vmcnt(" #N ")" : "+v"(K0), "+v"(K1), "+v"(V0), "+v"(V1) :: "memory")
#define AT_STORE(K0, K1, V0, V1, BUF) { LAS f16* kl2 = kl + (BUF) * KBUF; LAS f16* vl2 = vl + (BUF) * VBUF; \
            *(LAS u32x4*)kl2 = K0; *(LAS u32x4*)(kl2 + 32 * KROW) = K1; *(LAS u32x4*)vl2 = V0; *(LAS u32x4*)(vl2 + 64 * VROW) = V1; }
        u32x4 ka0, ka1, va0, va1, kb0, kb1, vb0, vb1;
        asm volatile("s_waitcnt vmcnt(0)" ::: "memory");
        AT_LOAD(ka0, ka1, va0, va1, 1)
        AT_LOAD(kb0, kb1, vb0, vb1, 2)
        __syncthreads();
        for (int kt = 0; kt < nkt; kt += 2) {
            { const u64 mcur = MK[(r >> 2) * 32 + kt];
              attn_tile64(Kb, Vb, (unsigned)mcur, (unsigned)(mcur >> 32), qf, oacc, mrun, lrun, r, hh); }
            AT_WAIT(4, ka0, ka1, va0, va1);
            AT_STORE(ka0, ka1, va0, va1, 1)
            AT_LOAD(ka0, ka1, va0, va1, kt + 3)
            __syncthreads();
            if (kt + 1 >= nkt) break;
            { const u64 mcur = MK[(r >> 2) * 32 + kt + 1];
              attn_tile64(Kb + KBUF, Vb + VBUF, (unsigned)mcur, (unsigned)(mcur >> 32), qf, oacc, mrun, lrun, r, hh); }
            AT_WAIT(4, kb0, kb1, vb0, vb1);
            AT_STORE(kb0, kb1, vb0, vb1, 0)
            AT_LOAD(kb0, kb1, vb0, vb1, kt + 4)
            __syncthreads();
        }
        asm volatile("s_waitcnt vmcnt(0)" : "+v"(ka0), "+v"(ka1), "+v"(va0), "+v"(va1), "+v"(kb0), "+v"(kb1), "+v"(vb0), "+v"(vb1) :: "memory");
#undef AT_GLD
#undef AT_LOAD
#undef AT_WAIT
#undef AT_STORE
        const float invl = 1.f / lrun;
        const size_t obase = (tok0 + query) * D + head * 128;
        h4 sgq[4][4];
#pragma unroll
        for (int mt = 0; mt < 4; ++mt)
#pragma unroll
            for (int g4 = 0; g4 < 4; ++g4) sgq[mt][g4] = *(const h4*)(SG + obase + 32 * mt + 8 * g4 + 4 * hh);
#pragma unroll
        for (int mt = 0; mt < 4; ++mt)
#pragma unroll
            for (int g4 = 0; g4 < 4; ++g4) {
                const int d = 32 * mt + 8 * g4 + 4 * hh;
                const h4 sg = sgq[mt][g4]; h4 o;
#pragma unroll
                for (int e = 0; e < 4; ++e) o[e] = (f16)(oacc[mt][4 * g4 + e] * invl * silu_f((float)sg[e]));
                *(h4*)(AO + obase + d) = o;
            }
    }
}

__device__ __forceinline__ f32x4 ld_h4f(const f16* p_) { const h4 t = *(const h4*)p_; return (f32x4){(float)t[0], (float)t[1], (float)t[2], (float)t[3]}; }
__device__ __forceinline__ void ph_conv(CParams& p, const int wv_s) {
    const f16* XB = (const f16*)(p.ws + WS_XB); f16* XC = (f16*)(p.ws + WS_XC);
    const long gtid = (long)blockIdx.x * NTHR + tid_fresh(), gth = (long)gridDim.x * NTHR;
    constexpr int RUN = 16, NRUN = MT / RUN;
    for (long it = gtid; it < (long)NRUN * 256; it += gth) {
        const int run = (int)(it >> 8), c = (int)(it & 255) * 4, row0 = run * RUN;
        const f32x4 w0 = *(const f32x4*)(p.conv_w + c), w1 = *(const f32x4*)(p.conv_w + D + c), w2 = *(const f32x4*)(p.conv_w + 2 * D + c), w3 = *(const f32x4*)(p.conv_w + 3 * D + c);
        const f32x4 bias = *(const f32x4*)(p.conv_b + c);
        const f32x4 z4 = (f32x4){0.f, 0.f, 0.f, 0.f};
        f32x4 xm1 = z4, xm2 = z4, xm3 = z4;
        if (row0 < MP) { if ((row0 & (SEQ - 1)) != 0) { xm1 = ld_h4f(XB + (size_t)(row0 - 1) * D + c); xm2 = ld_h4f(XB + (size_t)(row0 - 2) * D + c); xm3 = ld_h4f(XB + (size_t)(row0 - 3) * D + c); } }
#pragma unroll
        for (int i = 0; i < RUN; ++i) {
            const int row = row0 + i;
            const f32x4 x0 = ld_h4f(XB + (size_t)row * D + c);
            if (row < MP) { const int pos = row & (SEQ - 1);
                if (pos >= SEQ - 3) *(f32x4*)(p.out + O_CP + ((size_t)(row >> 11) * 3 + (pos - (SEQ - 3))) * D + c) = x0;
            } else { const int rs = row - MP, b = rs >> 2, t = rs & 3;
                if (t == 0) { const float* st = p.st_conv + (size_t)b * 3 * D + c; xm3 = *(const f32x4*)st; xm2 = *(const f32x4*)(st + D); xm1 = *(const f32x4*)(st + 2 * D); }
                else *(f32x4*)(p.out + O_CS + ((size_t)b * 3 + (t - 1)) * D + c) = x0;
            }
            const f32x4 y = w3 * x0 + w2 * xm1 + w1 * xm2 + w0 * xm3 + bias;
            *(h4*)(XC + (size_t)row * D + c) = to_h4(y);
            if (row >= MP) *(h4*)((f16*)(p.ws + WS_XCS) + as16_off(row - MP, c)) = to_h4(y);
            xm3 = xm2; xm2 = xm1; xm1 = x0;
        }
    }
}

__device__ __forceinline__ void ph_scanA(CParams& p, const int wv_s) {
    const unsigned* LB = (const unsigned*)(p.ws + WS_LA); float* TOT = (float*)(p.ws + WS_TOT);
    const long gtid = (long)blockIdx.x * NTHR + tid_fresh(), gth = (long)gridDim.x * NTHR;
    for (long it = gtid; it < (long)NB * 16 * D; it += gth) {
        const int ch = (int)(it & 1023), chunk = (int)(it >> 10) & 15, b = (int)(it >> 14);
        if (chunk == 15) continue;
        const size_t base = ((size_t)b * SEQ + chunk * 128) * D + ch;
        float Ap = 1.f, h = 0.f;
#pragma unroll 16
        for (int t = 0; t < 128; ++t) { float a, bb; unpack_lb(LB[base + (size_t)t * D], a, bb); Ap *= a; h = a * h + bb; }
        TOT[(((size_t)b * 16 + chunk) * D + ch) * 2] = Ap; TOT[(((size_t)b * 16 + chunk) * D + ch) * 2 + 1] = h;
    }
}

__device__ __forceinline__ void ph_scanB(CParams& p, const int wv_s) {
    const unsigned* LB = (const unsigned*)(p.ws + WS_LA); const float* TOT = (const float*)(p.ws + WS_TOT);
    const f16* G1 = (const f16*)(p.ws + WS_G1); f16* U = (f16*)(p.ws + WS_U);
    const long gtid = (long)blockIdx.x * NTHR + tid_fresh(), gth = (long)gridDim.x * NTHR;
    for (long it = gtid; it < (long)NB * 16 * D + DB * D; it += gth) {
        if (it < (long)NB * 16 * D) {
            const int ch = (int)(it & 1023), chunk = (int)(it >> 10) & 15, b = (int)(it >> 14);
            float h = 0.f;
            for (int c2 = 0; c2 < chunk; ++c2) { const f32x2 ab = *(const f32x2*)(TOT + (((size_t)b * 16 + c2) * D + ch) * 2); h = ab[0] * h + ab[1]; }
            const size_t base = ((size_t)b * SEQ + chunk * 128) * D + ch;
#pragma unroll 16
            for (int t = 0; t < 128; ++t) { const size_t o = base + (size_t)t * D; float a, bb; unpack_lb(LB[o], a, bb); h = a * h + bb; U[o] = (f16)(h * (float)G1[o]); }
            if (chunk == 15) p.out[O_HP + (size_t)b * D + ch] = h;
        } else {
            const int i2 = (int)(it - (long)NB * 16 * D); const int ch = i2 & 1023, b = i2 >> 10;
            float h = p.st_h[(size_t)b * D + ch];
            const size_t base = ((size_t)MP + b * 4) * D + ch;
#pragma unroll
            for (int t = 0; t < 4; ++t) { const size_t o = base + (size_t)t * D; float a, bb; unpack_lb(LB[o], a, bb); h = a * h + bb; ((f16*)(p.ws + WS_US))[as16_off(b * 4 + t, ch)] = (f16)(h * (float)G1[o]); }
            p.out[O_HS + (size_t)b * D + ch] = h;
        }
    }
}

template <class ORDER> __device__ __forceinline__ void ph_gates_prep(CParams& p, const ORDER& S, const int wv_s) {
    const int tid = tid_fresh();
    f16* XC = (f16*)(p.ws + WS_XC); const float* XCH = (const float*)(p.ws + WS_XCH); const float* XBT = (const float*)(p.ws + WS_XBT);
    {
        int upm[4], ublk[4];
#pragma unroll
        for (int i = 0; i < 4; ++i) { pg::Unit u; const bool ok = S.next(i, u); upm[i] = ok ? u.pm : 0; ublk[i] = ok ? (u.pn >> 1) : 0; }
        float yv[6], ta[6], tb[6], tc[6], wa[6], wb[6], wc[6]; int orow[6], ocol[6], orr[6];
#pragma unroll
        for (int k = 0; k < 6; ++k) {
            const int f = tid + k * NTHR, i = f / 768, e = f - i * 768, r = e >> 8;
            const int pm = i == 0 ? upm[0] : (i == 1 ? upm[1] : (i == 2 ? upm[2] : upm[3])), blk = i == 0 ? ublk[0] : (i == 1 ? ublk[1] : (i == 2 ? ublk[2] : ublk[3]));
            const int c = blk * 256 + (e & 255);
            const bool act = (pm & 7) != 0;
            const int pmm = act ? pm : 1;
            const float* t = XBT + (size_t)(pmm - 1) * 3 * D + c;
            ta[k] = t[0]; tb[k] = t[D]; tc[k] = t[2 * D];
            wa[k] = p.conv_w[c]; wb[k] = p.conv_w[D + c]; wc[k] = p.conv_w[2 * D + c];
            yv[k] = XCH[((size_t)pmm * 3 + r) * D + c];
            orow[k] = act ? pmm * 256 + r : -1; ocol[k] = c; orr[k] = r;
        }
#pragma unroll
        for (int k = 0; k < 6; ++k) {
            float y = yv[k];
            if (orr[k] == 0) y += wc[k] * tc[k] + wb[k] * tb[k] + wa[k] * ta[k]; else if (orr[k] == 1) y += wb[k] * tc[k] + wa[k] * tb[k]; else y += wa[k] * tc[k];
            if (orow[k] >= 0) XC[(size_t)orow[k] * D + ocol[k]] = (f16)y;
        }
        pg::Unit u;
        for (int i = 4; S.next(i, u); ++i) {
            const int pm = u.pm, blk = u.pn >> 1;
            if ((pm & 7) == 0) continue;
            for (int e = tid; e < 768; e += NTHR) {
                const int r = e >> 8, c = blk * 256 + (e & 255);
                const float* t = XBT + (size_t)(pm - 1) * 3 * D + c;
                const float w0 = p.conv_w[c], w1 = p.conv_w[D + c], w2 = p.conv_w[2 * D + c];
                float y = XCH[((size_t)pm * 3 + r) * D + c];
                if (r == 0) y += w2 * t[2 * D] + w1 * t[D] + w0 * t[0]; else if (r == 1) y += w1 * t[2 * D] + w0 * t[D]; else y += w0 * t[2 * D];
                XC[((size_t)pm * 256 + r) * D + c] = (f16)y;
            }
        }
    }
    const f16* XB = (const f16*)(p.ws + WS_XB);
    for (int un = (int)blockIdx.x; un < 64; un += (int)gridDim.x) {
        const int blk = un >> 4;
#pragma unroll 2
        for (int it = tid; it < DB * 64; it += NTHR) {
            const int b = it >> 6, c = blk * 256 + (it & 63) * 4;
            const f32x4 w0 = *(const f32x4*)(p.conv_w + c), w1 = *(const f32x4*)(p.conv_w + D + c), w2 = *(const f32x4*)(p.conv_w + 2 * D + c), w3 = *(const f32x4*)(p.conv_w + 3 * D + c);
            const f32x4 bias = *(const f32x4*)(p.conv_b + c);
            const float* st = p.st_conv + (size_t)b * 3 * D + c;
            f32x4 xm3 = *(const f32x4*)st, xm2 = *(const f32x4*)(st + D), xm1 = *(const f32x4*)(st + 2 * D);
            f32x4 xs4[4];
#pragma unroll
            for (int t = 0; t < 4; ++t) xs4[t] = ld_h4f(XB + (size_t)(MP + b * 4 + t) * D + c);
#pragma unroll
            for (int t = 0; t < 4; ++t) {
                const int rs = b * 4 + t;
                const f32x4 x0 = xs4[t];
                if (t > 0) *(f32x4*)(p.out + O_CS + ((size_t)b * 3 + (t - 1)) * D + c) = x0;
                const f32x4 y = w3 * x0 + w2 * xm1 + w1 * xm2 + w0 * xm3 + bias;
                *(h4*)(XC + (size_t)(MP + rs) * D + c) = to_h4(y);
                *(h4*)((f16*)(p.ws + WS_XCS) + as16_off(rs, c)) = to_h4(y);
                xm3 = xm2; xm2 = xm1; xm1 = x0;
            }
        }
    }
    asm volatile("s_waitcnt vmcnt(0)" ::: "memory");
    __syncthreads();
}

__device__ __forceinline__ void ph_scan(CParams& p, LAS unsigned char* lds, const int wv_s) {
    const unsigned* LB = (const unsigned*)(p.ws + WS_LA);
    const f16* G1 = (const f16*)(p.ws + WS_G1); f16* U = (f16*)(p.ws + WS_U);
    const int tid = tid_fresh();
    const int chunk = tid >> 4, quad = tid & 15;
    LAS float* AG = (LAS float*)lds;
    LAS float* CR = (LAS float*)(lds + 16384);
    constexpr float KL = 0.015625f * 1.44269504f;
    const int nk = ((NB * 16 - (int)blockIdx.x + (int)gridDim.x - 1) / (int)gridDim.x) * 4;
    auto base_of = [](int k, int chunk, int quad) -> size_t { const int item = (int)blockIdx.x + (k >> 2) * (int)gridDim.x; return ((size_t)(item >> 4) * SEQ + (k & 3) * 512 + chunk * 16) * D + (item & 15) * 64 + quad * 4; };
    u32x4 lbv[16], nlb[16]; h4 gv[16];
    if (nk > 0) { const unsigned* lbp = LB + base_of(0, chunk, quad);
#pragma unroll
        for (int i = 0; i < 16; ++i) lbv[i] = *(const u32x4*)(lbp + (size_t)i * D); }
    float hc = 0.f;
    for (int k = 0; k < nk; ++k) {
        const size_t base = base_of(k, chunk, quad);
        const f16* gp = G1 + base; f16* up = U + base;
        asm volatile("" : "+v"(gp), "+v"(up));
#pragma unroll
        for (int i = 0; i < 16; ++i) gv[i] = *(const h4*)(gp + (size_t)i * D);
        if (k + 1 < nk) { const unsigned* lbp = LB + base_of(k + 1, chunk, quad);
#pragma unroll
            for (int i = 0; i < 16; ++i) nlb[i] = *(const u32x4*)(lbp + (size_t)i * D); }
        f32x4 ls = {0.f, 0.f, 0.f, 0.f}, h = {0.f, 0.f, 0.f, 0.f};
#pragma unroll
        for (int i = 0; i < 16; ++i)
#pragma unroll
            for (int e = 0; e < 4; ++e) { const unsigned w = lbv[i][e]; const h2v t = __builtin_bit_cast(h2v, w); const float l = (float)t[0]; ls[e] += l; h[e] = __builtin_amdgcn_exp2f(l * KL) * h[e] + (float)t[1]; }
        { LAS f32x4* ag = (LAS f32x4*)(AG + (size_t)tid * 8);
          ag[0] = (f32x4){__builtin_amdgcn_exp2f(ls[0] * KL), h[0], __builtin_amdgcn_exp2f(ls[1] * KL), h[1]};
          ag[1] = (f32x4){__builtin_amdgcn_exp2f(ls[2] * KL), h[2], __builtin_amdgcn_exp2f(ls[3] * KL), h[3]}; }
        __syncthreads();
        if (tid < 64) {
            if ((k & 3) == 0) hc = 0.f;
#pragma unroll
            for (int c = 0; c < 32; ++c) { const f32x2 ah = *(LAS f32x2*)(AG + (c * 64 + tid) * 2); CR[c * 64 + tid] = hc; hc = ah[0] * hc + ah[1]; }
            if ((k & 3) == 3) { const int item = (int)blockIdx.x + (k >> 2) * (int)gridDim.x; p.out[O_HP + (size_t)(item >> 4) * D + (item & 15) * 64 + tid] = hc; }
        }
        __syncthreads();
        f32x4 hh = *(LAS f32x4*)(CR + (size_t)tid * 4);
#pragma unroll
        for (int i = 0; i < 16; ++i) asm volatile("" : "+v"(lbv[i]));
#pragma unroll
        for (int i = 0; i < 16; ++i) {
            h4 u;
#pragma unroll
            for (int e = 0; e < 4; ++e) { const unsigned w = lbv[i][e]; const h2v t = __builtin_bit_cast(h2v, w); hh[e] = __builtin_amdgcn_exp2f((float)t[0] * KL) * hh[e] + (float)t[1]; u[e] = (f16)(hh[e] * (float)gv[i][e]); }
            *(h4*)(up + (size_t)i * D) = u;
        }
#pragma unroll
        for (int i = 0; i < 16; ++i) lbv[i] = nlb[i];
        __syncthreads();
    }
    const long gtid = (long)blockIdx.x * NTHR + tid, gth = (long)gridDim.x * NTHR;
    for (long it = gtid; it < (long)DB * D; it += gth) {
        const int ch = (int)it & 1023, b = (int)(it >> 10);
        float h = p.st_h[(size_t)b * D + ch];
        const size_t base = ((size_t)MP + b * 4) * D + ch;
#pragma unroll
        for (int t = 0; t < 4; ++t) { const size_t o = base + (size_t)t * D; float a, bb; unpack_lb(LB[o], a, bb); h = a * h + bb; ((f16*)(p.ws + WS_US))[as16_off(b * 4 + t, ch)] = (f16)(h * (float)G1[o]); }
        p.out[O_HS + (size_t)b * D + ch] = h;
    }
}

constexpr int NPHASE = 14;
extern __shared__ __attribute__((aligned(16))) unsigned char dyn_lds[];

#define PHASE_PARAMS() CParams* kp_ = (CParams*)__builtin_amdgcn_kernarg_segment_ptr(); asm volatile("" : "+s"(kp_)); CParams& p = *kp_; \
    float* ADA = (float*)(p.ws + WS_ADA); f16* H = (f16*)(p.ws + WS_H); float* X1 = (float*)(p.ws + WS_X1); (void)ADA; (void)H; (void)X1;
__global__ void __launch_bounds__(NTHR, 2) fwd_kernel(Params p_arg) {
    LAS unsigned char* lds = (LAS unsigned char*)dyn_lds;
    const int wv_s = __builtin_amdgcn_readfirstlane((int)(threadIdx.x >> 6));
#if N_LAUNCH_MODE == 1
    const int lo = 0, hi = NPHASE; (void)p_arg;
    if (threadIdx.x == 0) *(LAS u32x4*)(lds + LDS_BARW) = (u32x4){0u, 0u, 0u, 0u};
    __syncthreads();
    XcdBarrier bar = xcd_barrier_post((unsigned*)(p_arg.ws + WS_CTL), (volatile LAS unsigned*)(lds + LDS_BARW));
#define SEAM(k) do { if ((k) + 1 < hi) xcd_barrier(bar); } while (0)
#else
    const int lo = (int)p_arg.ph_lo, hi = (int)p_arg.ph_hi;
#define SEAM(k) do { } while (0)
#endif
#ifndef PH_MASK
#define PH_MASK 0xFFFF
#endif
#define IN(k) ((((PH_MASK) >> (k)) & 1) && lo <= (k) && (k) < hi)
#ifndef DUP_MASK
#define DUP_MASK 0
#endif
#define DUPQ(k) ((((DUP_MASK) >> (k)) & 1) != 0)

    if (IN(0)) { PHASE_PARAMS(); ph0_prologue(p, lds, wv_s); if (DUPQ(0)) { ph0_prologue(p, lds, wv_s); } SEAM(0); }
    if (IN(1)) { PHASE_PARAMS(); ph_modulate(p.x_p, p.x_s, p.norm_g, ADA, H, (f16*)(p.ws + WS_HS), wv_s);
        {
            f16* SHS = (f16*)(p.ws + WS_SHS); const long gtid = (long)blockIdx.x * NTHR + tid_fresh(), gth = (long)gridDim.x * NTHR;
            for (long e = gtid; e < 128 * D; e += gth) { const int r = (int)(e >> 10), k = (int)(e & 1023); SHS[as16_off(r, k)] = r < 48 ? (f16)ADA[((size_t)48 + r) * 3072 + k] : (f16)0.f; }
        }
        SEAM(1); }
    if (IN(2)) { PHASE_PARAMS();
        const EmitInproj em{(f16*)(p.ws + WS_Q), (f16*)(p.ws + WS_QI), (f16*)(p.ws + WS_SG), (f16*)(p.ws + WS_VT), (float*)(p.ws + WS_WI), p.out};
        {
            const int G = (int)gridDim.x, rem = (MP / 256 * (NIN / 256)) % G, lo = rem == 0 ? 0 : rem;
            thin_gemm(lds, (const f16*)(p.ws + WS_HS), (const f16*)(p.ws + WS_WIN), D, NIN, em, wv_s, lo, G - lo);
            thin_gemm(lds, (const f16*)(p.ws + WS_SHS), (const f16*)(p.ws + WS_WLIN), D, 2 * D, EmitSW{(float*)(p.ws + WS_SW)}, wv_s, lo, G - lo);
        }
        pg::Gemm g{H, (const f16*)(p.ws + WS_WIN), D, D, D};
        pg::GridOrder<MapFull> S; S.init(MP / 256, NIN / 256, (int)gridDim.x, (int)blockIdx.x, MapFull{D, D});
        const EpiMain<EmitInproj> E{em};
        pg::gemm_phase(lds, g, S, E, wv_s); if (DUPQ(2)) { pg::gemm_phase(lds, g, S, E, wv_s); } if (DUPQ(18)) { const EpiMain<EmitNull> EN{EmitNull{}}; pg::gemm_phase(lds, g, S, EN, wv_s); }
        SEAM(2);
    }
    if (IN(3)) { PHASE_PARAMS(); ph3_fixup(p, wv_s); SEAM(3); }
    if (IN(4)) { PHASE_PARAMS(); if (wv_s < 4) { phA_sample(p, lds, wv_s); phA_prompt<true>(p, lds, wv_s); } else { phA_prompt<true>(p, lds, wv_s); phA_sample(p, lds, wv_s); }     if (DUPQ(15)) { phA_sample(p, lds, wv_s); } if (DUPQ(16)) { phA_prompt<true>(p, lds, wv_s); } if (DUPQ(17)) { phA_prompt<false>(p, lds, wv_s); } SEAM(4); }
    if (IN(5)) { PHASE_PARAMS(); phB_sample(p, lds, wv_s); phB_attention(p, lds, wv_s); if (DUPQ(5)) { phB_sample(p, lds, wv_s); } if (DUPQ(14)) { phB_attention(p, lds, wv_s); } SEAM(5); }
    if (IN(6)) { PHASE_PARAMS();
        const float* ADA1 = ADA + (size_t)48 * 3072;
        const EmitResidHS ems{p.x_s, ADA, ADA1, p.norm_g + D, X1 + (size_t)MP * D, (f16*)(p.ws + WS_HS), (float*)(p.ws + WS_SSPS)};
        thin_gemm(lds, (const f16*)(p.ws + WS_AOS), (const f16*)(p.ws + WS_WO0), D, D, ems, wv_s);
        pg::Gemm g{(const f16*)(p.ws + WS_AO), (const f16*)(p.ws + WS_WO0), D, D, D};
        pg::GridOrder<MapFull> S; S.init(MP / 256, D / 256, (int)gridDim.x, (int)blockIdx.x, MapFull{D, D});
        const EpiResidH E{p.x_p, ADA, ADA1, p.norm_g + D, X1, H, (float*)(p.ws + WS_SSP)};
        pg::gemm_phase(lds, g, S, E, wv_s); if (DUPQ(6)) { pg::gemm_phase(lds, g, S, E, wv_s); }
        SEAM(6);
    }
    if (IN(8)) { PHASE_PARAMS();
        const EmitLruIn em{(f16*)(p.ws + WS_XB), (f16*)(p.ws + WS_G1), (const float*)(p.ws + WS_SSPS), (const float*)(p.ws + WS_SW)};
        thin_gemm(lds, (const f16*)(p.ws + WS_HS), (const f16*)(p.ws + WS_WLIN), D, 2 * D, em, wv_s);
        pg::Gemm g{H, (const f16*)(p.ws + WS_WLIN), D, D, D};
        pg::GridOrder<MapFull> S; S.init(MP / 256, 2 * D / 256, (int)gridDim.x, (int)blockIdx.x, MapFull{D, D});
        const EpiLruIn E{em, (f16*)(p.ws + WS_XC), (float*)(p.ws + WS_XCH), (float*)(p.ws + WS_XBT), p.out, p.conv_w, p.conv_b, lds, (const float*)(p.ws + WS_SSP), (const float*)(p.ws + WS_SW)};
        pg::gemm_phase(lds, g, S, E, wv_s); if (DUPQ(8)) { pg::gemm_phase(lds, g, S, E, wv_s); }
        SEAM(8);
    }
    if (IN(10)) { PHASE_PARAMS();
        const EmitGates em{(const f16*)(p.ws + WS_XC), p.b_a, p.b_x, (const float*)(p.ws + WS_LS), (unsigned*)(p.ws + WS_LA)};
        pg::Gemm g{(const f16*)(p.ws + WS_XC), (const f16*)(p.ws + WS_WG), D, 256, 256};
        pg::GridOrder<MapGates> S; S.init(MP / 256, 8, (int)gridDim.x, (int)blockIdx.x, MapGates{});
        ph_gates_prep(p, S, wv_s);
        thin_gemm_gates(lds, (const f16*)(p.ws + WS_XCS), (const f16*)(p.ws + WS_WG), em, wv_s);
        const EpiGates E{em};
        pg::gemm_phase(lds, g, S, E, wv_s); if (DUPQ(10)) { pg::gemm_phase(lds, g, S, E, wv_s); }
        SEAM(10);
    }
    if (IN(11)) { PHASE_PARAMS(); ph_scan(p, lds, wv_s); if (DUPQ(11)) { ph_scan(p, lds, wv_s); } SEAM(11); }
    if (IN(13)) { PHASE_PARAMS();
        const EmitResid em{X1, X1 + (size_t)MP * D, ADA + (size_t)48 * 3072, p.out + O_Y, p.out + O_YS};
        thin_gemm(lds, (const f16*)(p.ws + WS_US), (const f16*)(p.ws + WS_WLO), D, D, em, wv_s);
        pg::Gemm g{(const f16*)(p.ws + WS_U), (const f16*)(p.ws + WS_WLO), D, D, D};
        pg::GridOrder<MapFull> S; S.init(MP / 256, D / 256, (int)gridDim.x, (int)blockIdx.x, MapFull{D, D});
        const EpiResidOut E{X1, ADA + (size_t)48 * 3072, p.out + O_Y};
        pg::gemm_phase(lds, g, S, E, wv_s); if (DUPQ(13)) { pg::gemm_phase(lds, g, S, E, wv_s); }
    }
#undef IN
#undef SEAM
}

extern "C" void kernel_launch(void* const* d_in, const int* in_sizes, int n_in, void* d_out, int out_size, void* d_ws, size_t ws_size, hipStream_t stream) {
    static int grid = 0;
    if (grid == 0) {
        if (n_in != 26 || (size_t)out_size != O_END || ws_size < WS_END) { fprintf(stderr, "kernel_launch: unexpected shapes: n_in %d out %d (want %zu) ws %zu (want %zu)\n", n_in, out_size, (size_t)O_END, ws_size, (size_t)WS_END); grid = -1; return; }
        int dev = 0, cus = 0, per_cu = 0;
        if (hipGetDevice(&dev) != hipSuccess || hipDeviceGetAttribute(&cus, hipDeviceAttributeMultiprocessorCount, dev) != hipSuccess) { grid = -1; return; }
        if (hipFuncSetAttribute((const void*)fwd_kernel, hipFuncAttributeMaxDynamicSharedMemorySize, LDS_BYTES) != hipSuccess) { fprintf(stderr, "kernel_launch: hipFuncSetAttribute failed\n"); grid = -1; return; }
        if (hipOccupancyMaxActiveBlocksPerMultiprocessor(&per_cu, (const void*)fwd_kernel, NTHR, LDS_BYTES) != hipSuccess || per_cu < 1)
            fprintf(stderr, "kernel_launch: occupancy query reports %d blocks per CU\n", per_cu);
        (void)hipGetLastError();
        grid = cus < 256 ? cus : 256;
    }
    if (grid < 0) return;
    (void)hipMemsetAsync((char*)d_ws + WS_CTL, 0, 65536, stream);
    Params p{};
    p.x_p = (const float*)d_in[0]; p.x_s = (const float*)d_in[1]; p.cache_k = (const float*)d_in[2]; p.cache_v = (const float*)d_in[3]; p.cache_ik = (const float*)d_in[4];
    p.st_conv = (const float*)d_in[5]; p.st_h = (const float*)d_in[6]; p.page_table = (const int*)d_in[7]; p.c_p = (const float*)d_in[8]; p.c_s = (const float*)d_in[9];
    p.norm_g = (const float*)d_in[10]; p.ada_w = (const float*)d_in[11]; p.ada_b = (const float*)d_in[12]; p.w_in = (const float*)d_in[13]; p.q_norm = (const float*)d_in[14];
    p.k_norm = (const float*)d_in[15]; p.w_out0 = (const float*)d_in[16]; p.lw_in = (const float*)d_in[17]; p.conv_w = (const float*)d_in[18]; p.conv_b = (const float*)d_in[19];
    p.w_a = (const float*)d_in[20]; p.b_a = (const float*)d_in[21]; p.w_x = (const float*)d_in[22]; p.b_x = (const float*)d_in[23]; p.lam = (const float*)d_in[24]; p.lw_out = (const float*)d_in[25];
    p.out = (float*)d_out; p.ws = (unsigned char*)d_ws;
#if N_LAUNCH_MODE == 1
    p.ph_lo = 0; p.ph_hi = NPHASE;
    hipLaunchKernelGGL(fwd_kernel, dim3(grid), dim3(NTHR), LDS_BYTES, stream, p);
#else
    for (int k = 0; k < NPHASE; ++k) { p.ph_lo = k; p.ph_hi = k + 1; hipLaunchKernelGGL(fwd_kernel, dim3(grid), dim3(NTHR), LDS_BYTES, stream, p); }
#endif
    const hipError_t le = hipPeekAtLastError();
    if (le != hipSuccess) fprintf(stderr, "kernel_launch: launch failed: %s\n", hipGetErrorName(le));
}
```
